# Optimizing an MI355X kernel written in HIP

```python
import jax, jax.numpy as jnp
from jax import lax
import numpy as np

D_MODEL = 2048
BATCH = 4
SEQ = 4096
DEPTH = 1

N_ATT_HEADS = 8
HEAD_DIM = 128
ATT_WIDTH = N_ATT_HEADS * HEAD_DIM
MOBA_BLOCK = 256
MOBA_TOPK = 3
Q_CHUNK = 128
N_SGU_GROUPS = 8
SGU_GROUP_DIM = 128
SGU_WIDTH = N_SGU_GROUPS * SGU_GROUP_DIM
SGU_CHUNK = 128
IN_SPLITS = (ATT_WIDTH, ATT_WIDTH, ATT_WIDTH, ATT_WIDTH,
             SGU_WIDTH, SGU_WIDTH, SGU_WIDTH,
             D_MODEL, D_MODEL)
IN_WIDTH = 4 * ATT_WIDTH + 3 * SGU_WIDTH + 2 * D_MODEL
EPS = 1e-6
NEG_INF = -1e30

kernel_name = "hybrid_moba_gmlp_gated_layer"


def rms_norm(x, g):
    xf = x.astype(jnp.float32)
    y = xf * lax.rsqrt(jnp.mean(xf * xf, axis=-1, keepdims=True) + EPS)
    return (y * g.astype(jnp.float32)).astype(x.dtype)


def moba_attention(q, k, v):
    B, S, H, Dh = q.shape
    nb = -(-S // MOBA_BLOCK)
    s_pad = nb * MOBA_BLOCK
    topk = min(MOBA_TOPK, nb)
    nc = S // Q_CHUNK
    scale = Dh ** -0.5

    qh = q.transpose(0, 2, 1, 3)
    pad = ((0, 0), (0, 0), (0, s_pad - S), (0, 0))
    kh = jnp.pad(k.transpose(0, 2, 1, 3), pad)
    vh = jnp.pad(v.transpose(0, 2, 1, 3), pad)
    k_blocks = kh.reshape(B, H, nb, MOBA_BLOCK, Dh)
    v_blocks = vh.reshape(B, H, nb, MOBA_BLOCK, Dh)
    k_mean = jnp.mean(k_blocks.astype(jnp.float32), axis=3)
    q_chunks = qh.reshape(B, H, nc, Q_CHUNK, Dh).transpose(2, 0, 1, 3, 4)

    bi = jnp.arange(B)[:, None, None, None]
    hi = jnp.arange(H)[None, :, None, None]
    blk_ids = jnp.arange(nb)

    def one_chunk(args):
        qc, c = args
        q_pos = c * Q_CHUNK + jnp.arange(Q_CHUNK)
        cur = (c * Q_CHUNK) // MOBA_BLOCK
        gate = jnp.einsum('bhqd,bhnd->bhqn', qc.astype(jnp.float32), k_mean)
        gate = jnp.where(blk_ids < cur, gate, NEG_INF)
        _, idx = lax.top_k(gate, topk)
        valid = idx < cur
        k_sel = k_blocks[bi, hi, idx]
        v_sel = v_blocks[bi, hi, idx]
        s_past = jnp.einsum('bhqd,bhqknd->bhqkn', qc, k_sel,
                            preferred_element_type=jnp.float32) * scale
        s_past = jnp.where(valid[..., None], s_past, NEG_INF)
        k_own = lax.dynamic_index_in_dim(k_blocks, cur, axis=2, keepdims=False)
        v_own = lax.dynamic_index_in_dim(v_blocks, cur, axis=2, keepdims=False)
        s_own = jnp.einsum('bhqd,bhnd->bhqn', qc, k_own,
                           preferred_element_type=jnp.float32) * scale
        key_pos = cur * MOBA_BLOCK + jnp.arange(MOBA_BLOCK)
        s_own = jnp.where(key_pos[None, :] <= q_pos[:, None], s_own, NEG_INF)
        logits = jnp.concatenate(
            [s_past.reshape(B, H, Q_CHUNK, topk * MOBA_BLOCK), s_own], axis=-1)
        p = jax.nn.softmax(logits, axis=-1)
        p_past = p[..., :topk * MOBA_BLOCK].reshape(B, H, Q_CHUNK, topk, MOBA_BLOCK)
        p_own = p[..., topk * MOBA_BLOCK:]
        o = (jnp.einsum('bhqkn,bhqknd->bhqd', p_past.astype(v_sel.dtype), v_sel)
             + jnp.einsum('bhqn,bhnd->bhqd', p_own.astype(v_own.dtype), v_own))
        return o.astype(qc.dtype)

    out = lax.map(one_chunk, (q_chunks, jnp.arange(nc, dtype=jnp.int32)))
    return out.transpose(1, 0, 3, 2, 4).reshape(B, S, H * Dh)


def spatial_gating(u, v, v_norm_g, w_s, b_s):
    B, S, _ = u.shape
    n = S // SGU_CHUNK
    vg = rms_norm(v.reshape(B, S, N_SGU_GROUPS, SGU_GROUP_DIM), v_norm_g)
    vg = vg.reshape(B, n, SGU_CHUNK, N_SGU_GROUPS, SGU_GROUP_DIM)
    causal = jnp.tril(jnp.ones((SGU_CHUNK, SGU_CHUNK), dtype=bool))
    w = jnp.where(causal[None], w_s, jnp.zeros((), w_s.dtype))
    mixed = jnp.einsum('gts,bnsgc->bntgc', w, vg) + b_s.T[:, :, None]
    return u * mixed.reshape(B, S, SGU_WIDTH)


def hybrid_layer(x, norm_g, w_in, q_norm_g, k_norm_g, sgu_norm_g, w_s, b_s,
                 w_proj_a, w_proj_b, w_out):
    B, S, _ = x.shape
    h = rms_norm(x, norm_g)
    proj = h @ w_in
    cuts = [int(c) for c in np.cumsum(IN_SPLITS)[:-1]]
    q, k, v, z_a, u_b, v_b, z_b, g_a, g_b = jnp.split(proj, cuts, axis=-1)
    q = rms_norm(q.reshape(B, S, N_ATT_HEADS, HEAD_DIM), q_norm_g)
    k = rms_norm(k.reshape(B, S, N_ATT_HEADS, HEAD_DIM), k_norm_g)
    v = v.reshape(B, S, N_ATT_HEADS, HEAD_DIM)
    att = moba_attention(q, k, v)
    y_a = (att * jax.nn.silu(z_a)) @ w_proj_a
    sgu = spatial_gating(jax.nn.gelu(u_b), jax.nn.gelu(v_b), sgu_norm_g, w_s, b_s)
    y_b = (sgu * jax.nn.silu(z_b)) @ w_proj_b
    merged = jax.nn.sigmoid(g_a) * y_a + jax.nn.sigmoid(g_b) * y_b
    return x + merged @ w_out


def setup_inputs(seed: int = 0) -> dict:
    key = jax.random.key(seed)
    ks = jax.random.split(key, 12)
    f32 = jnp.float32
    x = jax.random.normal(ks[0], (BATCH, SEQ, D_MODEL), f32)
    norm_g = 1.0 + 0.02 * jax.random.normal(ks[1], (DEPTH, D_MODEL), f32)
    w_in = jax.random.normal(ks[2], (DEPTH, D_MODEL, IN_WIDTH), f32) * D_MODEL ** -0.5
    q_norm_g = 1.0 + 0.02 * jax.random.normal(ks[3], (DEPTH, HEAD_DIM), f32)
    k_norm_g = 1.0 + 0.02 * jax.random.normal(ks[4], (DEPTH, HEAD_DIM), f32)
    sgu_norm_g = 1.0 + 0.02 * jax.random.normal(ks[5], (DEPTH, SGU_GROUP_DIM), f32)
    w_spatial = jax.random.normal(ks[6], (DEPTH, N_SGU_GROUPS, SGU_CHUNK, SGU_CHUNK), f32) * SGU_CHUNK ** -0.5
    b_spatial = 1.0 + 0.1 * jax.random.normal(ks[7], (DEPTH, N_SGU_GROUPS, SGU_CHUNK), f32)
    w_proj_a = jax.random.normal(ks[8], (DEPTH, ATT_WIDTH, D_MODEL), f32) * ATT_WIDTH ** -0.5
    w_proj_b = jax.random.normal(ks[9], (DEPTH, SGU_WIDTH, D_MODEL), f32) * SGU_WIDTH ** -0.5
    w_out = jax.random.normal(ks[10], (DEPTH, D_MODEL, D_MODEL), f32) * D_MODEL ** -0.5
    return {"x": x, "norm_g": norm_g, "w_in": w_in, "q_norm_g": q_norm_g,
            "k_norm_g": k_norm_g, "sgu_norm_g": sgu_norm_g, "w_spatial": w_spatial,
            "b_spatial": b_spatial, "w_proj_a": w_proj_a, "w_proj_b": w_proj_b,
            "w_out": w_out}


def reference(x, norm_g, w_in, q_norm_g, k_norm_g, sgu_norm_g, w_spatial, b_spatial,
              w_proj_a, w_proj_b, w_out):
    for l in range(DEPTH):
        x = hybrid_layer(x, norm_g[l], w_in[l], q_norm_g[l], k_norm_g[l], sgu_norm_g[l],
                         w_spatial[l], b_spatial[l], w_proj_a[l], w_proj_b[l], w_out[l])
    return x
```

```cpp
#include <hip/hip_runtime.h>
#include <hip/hip_cooperative_groups.h>
#include <hip/hip_bf16.h>
#include <cstdio>
#include <cstdint>
namespace cg = cooperative_groups;

constexpr int DM = 2048, NB = 4, SEQ = 4096, TOK = NB * SEQ, NH = 8, HD = 128, LDP = 11264;
constexpr int C_Q = 0, C_K = 1024, C_V = 2048, C_ZA = 3072, C_UB = 4096, C_VB = 5120, C_ZB = 6144, C_GA = 7168, C_GB = 9216;
constexpr float EPS = 1e-6f;
constexpr size_t WS_BT1 = 0;
constexpr size_t WS_BT3 = WS_BT1 + (size_t)LDP * DM * 2;
constexpr size_t WS_BT4 = WS_BT3 + (size_t)DM * DM * 2;
constexpr size_t WS_PROJ = WS_BT4 + (size_t)DM * DM * 2;
constexpr size_t WS_MRG = WS_PROJ + (size_t)TOK * LDP * 2;
constexpr size_t WS_KMP = WS_MRG + (size_t)TOK * DM * 2;
constexpr size_t WS_H8 = WS_KMP + (size_t)64 * 8 * 2 * 128 * 4;
constexpr size_t WS_HSC = WS_H8 + (size_t)TOK * DM;
constexpr size_t WS_WSC = WS_HSC + (size_t)TOK * 4;
constexpr size_t WS_BAR = WS_WSC + (size_t)9216 * 4;
constexpr size_t WS_END = WS_BAR + 16384;
constexpr int NI8_TILES = 36, NBF_TILES = 8;
constexpr size_t WS_W8 = WS_BT1 + (size_t)NBF_TILES * 256 * DM * 2;
constexpr int LDS_XCH = 131072;
constexpr int LDS_MISC = LDS_XCH + 10240;
constexpr int LDS_TOTAL = LDS_MISC + 16;

namespace pg8 {
#define PG8_LAS __attribute__((address_space(3)))
typedef unsigned short bf16_t;
typedef short bf16x8 __attribute__((ext_vector_type(8)));
typedef float f32x4 __attribute__((ext_vector_type(4)));
typedef unsigned u32x4 __attribute__((ext_vector_type(4)));
typedef int i32x4 __attribute__((ext_vector_type(4)));
typedef float f32x2 __attribute__((ext_vector_type(2)));
constexpr int BM = 256, BK = 64, HALF = 128, HTB = HALF * BK * 2  , STAGE_BYTES = 8 * HTB, NXCD = 8, WGM = 8;

__host__ __device__ __forceinline__ int lds_byte(int r, int c) { const int st = (r >> 4) * 2 + (c >> 5), rr = r & 15, cc = c & 31, ob = rr * 64 + cc * 2; return st * 1024 + (ob ^ (((ob >> 9) & 1) << 5)); }
__host__ __device__ __forceinline__ void stage_rc(int b, int& R, int& C) { const int st = b / 1024, sb = b % 1024, swz = sb ^ (((sb >> 9) & 1) << 5); R = (st >> 1) * 16 + swz / 64; C = (st & 1) * 32 + (swz % 64) / 2; }
__host__ __device__ __forceinline__ int perm32(int rho) { const int n = rho >> 4, i = rho & 15; return 8 * (i >> 2) + 4 * n + (i & 3); }

struct Unit { int pm, pn; };
struct Gemm { const bf16_t* A; const bf16_t* Bt; int M, N, K; };

struct StaticOrder {
    int nM, nN, nwg, G, c, rep, wgm;
    __host__ __device__ void init(int M, int N, int G_, int c_, int rep_ = 1, int wgm_ = WGM) { nM = M / BM; nN = N / BM; nwg = nM * nN; G = G_; c = c_; rep = rep_; wgm = wgm_; }
    __host__ __device__ bool next(int i, Unit& u) const {
        long L = (long)i * G + c; if (L >= (long)nwg * rep) return false; L %= nwg;
        int wgid = (int)L; { const int q = nwg / NXCD, r = nwg % NXCD, xcd = wgid % NXCD, off = wgid / NXCD; wgid = (xcd < r ? xcd * (q + 1) : r * (q + 1) + (xcd - r) * q) + off; }
        const int nig = wgm * nN, gid = wgid / nig, fm = gid * wgm, gsz = (nM - fm) < wgm ? (nM - fm) : wgm;
        u.pm = fm + ((wgid % nig) % gsz); u.pn = (wgid % nig) / gsz; return true;
    }
    __device__ __forceinline__ void a_ready(const Unit&) const {}
    __device__ __forceinline__ void done(const Unit&) const {}
};

__device__ __forceinline__ unsigned cvt_pk_bf16(float lo, float hi) { unsigned r; asm volatile("v_cvt_pk_bf16_f32 %0, %1, %2" : "=v"(r) : "v"(lo), "v"(hi)); return r; }
__device__ __forceinline__ float bf_lo(unsigned w) { return __uint_as_float(w << 16); }
__device__ __forceinline__ float bf_hi(unsigned w) { return __uint_as_float(w & 0xffff0000u); }
__device__ __forceinline__ float sigmoid_f(float x) { return __builtin_amdgcn_rcpf(1.0f + __builtin_amdgcn_exp2f(-1.4426950408889634f * x)); }
__device__ __forceinline__ float silu_f(float x) { return x * sigmoid_f(x); }
__device__ __forceinline__ float gelu_f(float x) { const float u = 0.7978845608028654f * (x + 0.044715f * x * x * x); return x * sigmoid_f(2.0f * u); }

template <bool I8E> struct EpiProj {
    static constexpr bool PERM = true, AFTER_DRAIN = false, MIDHOOK = false;
    bf16_t* P; const float* qg; const float* kg; const float* sg; float* kmp; PG8_LAS float* xch;
    const float* hs; const float* wsc;
    __device__ __forceinline__ void mid(f32x4 (&)[2][2][4][2], const Unit&, int, int, int, int) const {}
    __device__ __forceinline__ void operator()(f32x4 (&acc)[2][2][4][2], const Unit& u, int wr, int wc, int fr, int fq) const {
        const int pn = I8E ? (u.pn < 16 ? u.pn : (u.pn < 20 ? u.pn + 4 : 28)) : (u.pn < 4 ? u.pn + 16 : u.pn + 20), colw = wc * 32 + 8 * fq;
        int lid = fr | (fq << 4); if constexpr (I8E) asm volatile("" : "+v"(lid));
        const int colw2 = wc * 32 + 8 * (lid >> 4), fr2 = lid & 15;
        if constexpr (I8E) {
            const float* hp = hs + u.pm * BM + wr * 64 + fr2; const float* wp = wsc + u.pn * BM + colw2;
#pragma unroll
            for (int bj = 0; bj < 2; ++bj) { const f32x4 c0 = *(const f32x4*)(wp + bj * HALF), c1 = *(const f32x4*)(wp + bj * HALF + 4);
#pragma unroll
                for (int ai = 0; ai < 2; ++ai)
#pragma unroll
                    for (int m = 0; m < 4; ++m) { const float rs = hp[ai * HALF + m * 16];
                        acc[ai][bj][m][0] = acc[ai][bj][m][0] * (c0 * rs); acc[ai][bj][m][1] = acc[ai][bj][m][1] * (c1 * rs); }
                asm volatile("" ::: "memory"); }
        }
        int act = 0; const float* gain = nullptr; bool km = false;
        if (pn < 4) { gain = qg; } else if (pn < 8) { gain = kg; km = true; } else if (pn < 12) { } else if (pn < 16) { act = 1; }
        else if (pn < 20) { act = 2; } else if (pn < 24) { act = 2; gain = sg; } else if (pn < 28) { act = 1; } else { act = 3; }
        const bool gate = I8E && u.pn >= 20;
        const int colbase = gate ? C_GA + 128 * (u.pn - 20) : pn * BM, bjoff = gate ? (C_GB - C_GA) : HALF;
        bf16_t* ubase = P + (size_t)(u.pm * BM) * LDP + colbase;
        const unsigned loff = (unsigned)((wr * 64 + fr2) * LDP + colw2) * 2u;
#define EPI_STORE_GROUP(ai, m) do { char* rowp_ = (char*)(ubase + ((ai) * HALF + (m) * 16) * LDP) + loff; _Pragma("unroll") for (int bj_ = 0; bj_ < 2; ++bj_) { \
            const f32x4 v0_ = acc[ai][bj_][m][0], v1_ = acc[ai][bj_][m][1]; u32x4 w_; w_.x = cvt_pk_bf16(v0_[0], v0_[1]); w_.y = cvt_pk_bf16(v0_[2], v0_[3]); w_.z = cvt_pk_bf16(v1_[0], v1_[1]); w_.w = cvt_pk_bf16(v1_[2], v1_[3]); \
            *(u32x4*)(rowp_ + bj_ * bjoff * 2) = w_; } } while (0)
        if (act != 0) {
            const float L2E = -1.4426950408889634f;
            const float c1 = ((act == 2) ? 1.5957691216057308f : 1.0f) * L2E, c3 = ((act == 2) ? 0.07135481627260025f : 0.0f) * L2E, ma = (act == 3) ? 0.0f : 1.0f, mb = (act == 3) ? 1.0f : 0.0f;
            const f32x2 C1 = {c1, c1}, C3 = {c3, c3}, MA = {ma, ma}, MB = {mb, mb}, ONE = {1.0f, 1.0f};
#pragma unroll
            for (int ai = 0; ai < 2; ++ai)
#pragma unroll
                for (int m = 0; m < 4; ++m) { f32x4 dB[2];
#pragma unroll
                    for (int bj = 0; bj < 2; ++bj)
#pragma unroll
                        for (int n = 0; n < 2; ++n) {
#pragma unroll
                            for (int j = 0; j < 4; j += 2) { const f32x2 x = {acc[ai][bj][m][n][j], acc[ai][bj][m][n][j + 1]};
                                const f32x2 t = x * ((x * x) * C3 + C1); f32x2 e; e.x = __builtin_amdgcn_exp2f(t.x); e.y = __builtin_amdgcn_exp2f(t.y);
                                const f32x2 d = e + ONE; f32x2 r; r.x = __builtin_amdgcn_rcpf(d.x); r.y = __builtin_amdgcn_rcpf(d.y);
                                if (bj == 1) { dB[n][j] = d.x; dB[n][j + 1] = d.y; }
                                const f32x2 o = (x * MA + MB) * r; acc[ai][bj][m][n][j] = o.x; acc[ai][bj][m][n][j + 1] = o.y; }
                            __builtin_amdgcn_sched_barrier(0); }
                    if constexpr (I8E) if (gate) {
#pragma unroll
                        for (int n = 0; n < 2; ++n)
#pragma unroll
                            for (int j = 0; j < 4; ++j) acc[ai][0][m][n][j] = acc[ai][0][m][n][j] * fminf(dB[n][j], 1e30f); }
                    if (!gain) { EPI_STORE_GROUP(ai, m); __builtin_amdgcn_sched_barrier(0); }
                }
        }
        unsigned xbo = (unsigned)(((wr * 64 + fr) * 2) * 4 + wc) * 4u; asm volatile("" : "+v"(xbo));
        PG8_LAS float* xb = (PG8_LAS float*)((PG8_LAS char*)xch + xbo);
        if (gain) {
#pragma unroll
            for (int ai = 0; ai < 2; ++ai)
#pragma unroll
                for (int m = 0; m < 4; ++m)
#pragma unroll
                    for (int bj = 0; bj < 2; ++bj) {
                        const f32x4 a = acc[ai][bj][m][0], b = acc[ai][bj][m][1];
                        float s = (a[0] * a[0] + a[1] * a[1]) + (a[2] * a[2] + a[3] * a[3]) + (b[0] * b[0] + b[1] * b[1]) + (b[2] * b[2] + b[3] * b[3]);
                        s += __shfl_xor(s, 16); s += __shfl_xor(s, 32);
                        if (fq == 0) xb[((ai * HALF + m * 16) * 2 + bj) * 4] = s;
                    }
            asm volatile("s_waitcnt lgkmcnt(0)" ::: "memory"); __builtin_amdgcn_s_barrier(); asm volatile("" ::: "memory");
            {
                const int t = threadIdx.x; const f32x4 pp = *(const PG8_LAS f32x4*)(xch + t * 4);
                xch[2048 + t] = __builtin_amdgcn_rsqf(((pp[0] + pp[1]) + (pp[2] + pp[3])) * (1.0f / 128.0f) + EPS); }
            asm volatile("s_waitcnt lgkmcnt(0)" ::: "memory"); __builtin_amdgcn_s_barrier(); asm volatile("" ::: "memory");
            const f32x4 g0 = *(const f32x4*)(gain + colw2), g1 = *(const f32x4*)(gain + colw2 + 4);
#pragma unroll
            for (int ai = 0; ai < 2; ++ai)
#pragma unroll
                for (int m = 0; m < 4; ++m) {
                    const f32x2 rs = *(const PG8_LAS f32x2*)(xch + 2048 + (ai * HALF + wr * 64 + m * 16 + fr) * 2);
                    acc[ai][0][m][0] = acc[ai][0][m][0] * rs[0] * g0; acc[ai][0][m][1] = acc[ai][0][m][1] * rs[0] * g1;
                    acc[ai][1][m][0] = acc[ai][1][m][0] * rs[1] * g0; acc[ai][1][m][1] = acc[ai][1][m][1] * rs[1] * g1;
                }
            if (km) {
#pragma unroll
                for (int bj = 0; bj < 2; ++bj)
#pragma unroll
                    for (int n = 0; n < 2; ++n) {
                        f32x4 cs = (f32x4){0.f, 0.f, 0.f, 0.f};
#pragma unroll
                        for (int ai = 0; ai < 2; ++ai)
#pragma unroll
                            for (int m = 0; m < 4; ++m) cs += acc[ai][bj][m][n];
#pragma unroll
                        for (int j = 0; j < 4; ++j) { float v = cs[j]; v += __shfl_xor(v, 1); v += __shfl_xor(v, 2); v += __shfl_xor(v, 4); v += __shfl_xor(v, 8); cs[j] = v; }
                        if (fr2 == 0) *(f32x4*)(kmp + ((size_t)(u.pm * 8 + (pn - 4) * 2 + bj) * 2 + wr) * 128 + colw2 + 4 * n) = cs;
                    }
            }
        }
        if (gain || act == 0) {
#pragma unroll
            for (int ai = 0; ai < 2; ++ai)
#pragma unroll
                for (int m = 0; m < 4; ++m) EPI_STORE_GROUP(ai, m);
        }
#undef EPI_STORE_GROUP
    }
};
struct EpiMerge {
    static constexpr bool PERM = true, AFTER_DRAIN = false, MIDHOOK = true;
    const bf16_t* P; bf16_t* O;
    __device__ __forceinline__ void mid(f32x4 (&acc)[2][2][4][2], const Unit& u, int wr, int wc, int fr, int fq) const {
        const bf16_t* ubase = P + (size_t)(u.pm * BM) * LDP + u.pn * BM + C_GA;
        unsigned loff = (unsigned)((wr * 64 + fr) * LDP + wc * 32 + 8 * fq) * 2u; asm volatile("" : "+v"(loff));
#pragma unroll
        for (int ai = 0; ai < 2; ++ai) {
            u32x4 a[4][2];
#pragma unroll
            for (int m = 0; m < 4; ++m)
#pragma unroll
                for (int bj = 0; bj < 2; ++bj) a[m][bj] = *(const u32x4*)((const char*)(ubase + (ai * HALF + m * 16) * LDP) + loff + bj * HALF * 2);
#pragma unroll
            for (int m = 0; m < 4; ++m)
#pragma unroll
                for (int bj = 0; bj < 2; ++bj) { const u32x4 w = a[m][bj]; f32x4 r0, r1;
                    r0[0] = bf_lo(w.x); r0[1] = bf_hi(w.x); r0[2] = bf_lo(w.y); r0[3] = bf_hi(w.y); r1[0] = bf_lo(w.z); r1[1] = bf_hi(w.z); r1[2] = bf_lo(w.w); r1[3] = bf_hi(w.w);
                    acc[ai][bj][m][0] *= r0; acc[ai][bj][m][1] *= r1; }
            asm volatile("" ::: "memory"); }
    }
    __device__ __forceinline__ void operator()(f32x4 (&acc)[2][2][4][2], const Unit& u, int wr, int wc, int fr, int fq) const {
        const bf16_t* ubase = P + (size_t)(u.pm * BM) * LDP + u.pn * BM + C_GB;
        bf16_t* obase = O + (size_t)(u.pm * BM) * DM + u.pn * BM;
        const unsigned loff = (unsigned)((wr * 64 + fr) * LDP + wc * 32 + 8 * fq) * 2u, ooff = (unsigned)((wr * 64 + fr) * DM + wc * 32 + 8 * fq) * 2u;
#pragma unroll
        for (int ai = 0; ai < 2; ++ai) {
            u32x4 bq[4][2];
#pragma unroll
            for (int m = 0; m < 4; ++m)
#pragma unroll
                for (int bj = 0; bj < 2; ++bj) bq[m][bj] = *(const u32x4*)((const char*)(ubase + (ai * HALF + m * 16) * LDP) + loff + bj * HALF * 2);
#pragma unroll
            for (int m = 0; m < 4; ++m) { char* orow = (char*)(obase + (ai * HALF + m * 16) * DM) + ooff;
#pragma unroll
                for (int bj = 0; bj < 2; ++bj) { const u32x4 b = bq[m][bj];
                    const f32x4 v0 = acc[ai][bj][m][0], v1 = acc[ai][bj][m][1];
                    u32x4 w; w.x = cvt_pk_bf16(v0[0] * fmaxf(bf_lo(b.x), 1e-30f), v0[1] * fmaxf(bf_hi(b.x), 1e-30f)); w.y = cvt_pk_bf16(v0[2] * fmaxf(bf_lo(b.y), 1e-30f), v0[3] * fmaxf(bf_hi(b.y), 1e-30f));
                    w.z = cvt_pk_bf16(v1[0] * fmaxf(bf_lo(b.z), 1e-30f), v1[1] * fmaxf(bf_hi(b.z), 1e-30f)); w.w = cvt_pk_bf16(v1[2] * fmaxf(bf_lo(b.w), 1e-30f), v1[3] * fmaxf(bf_hi(b.w), 1e-30f));
                    *(u32x4*)(orow + bj * HALF * 2) = w; } }
            asm volatile("" ::: "memory"); }
    }
};
struct EpiOut {
    static constexpr bool PERM = false, AFTER_DRAIN = false, MIDHOOK = false;
    const float* __restrict__ X; float* __restrict__ O;
    __device__ __forceinline__ void mid(f32x4 (&)[2][2][4][2], const Unit&, int, int, int, int) const {}
    __device__ __forceinline__ void operator()(f32x4 (&acc)[2][2][4][2], const Unit& u, int wr, int wc, int fr, int fq) const {
        const size_t r0i = (size_t)(u.pm * BM + wr * 64 + fr); const int col = u.pn * BM + wc * 32 + 4 * fq;
        f32x4 xq[4][2][2][2];
#define EO_LOAD(q) do { _Pragma("unroll") for (int mm = 0; mm < 2; ++mm) _Pragma("unroll") for (int bj = 0; bj < 2; ++bj) _Pragma("unroll") for (int n = 0; n < 2; ++n) \
            xq[q][mm][bj][n] = *(const f32x4*)(X + (r0i + ((q) >> 1) * HALF + (2 * ((q) & 1) + mm) * 16) * DM + col + bj * HALF + 16 * n); } while (0)
#define EO_STORE(q) do { _Pragma("unroll") for (int mm = 0; mm < 2; ++mm) _Pragma("unroll") for (int bj = 0; bj < 2; ++bj) _Pragma("unroll") for (int n = 0; n < 2; ++n) \
            *(f32x4*)(O + (r0i + ((q) >> 1) * HALF + (2 * ((q) & 1) + mm) * 16) * DM + col + bj * HALF + 16 * n) = xq[q][mm][bj][n] + acc[(q) >> 1][bj][2 * ((q) & 1) + mm][n]; } while (0)
        EO_LOAD(0); EO_LOAD(1); asm volatile("" ::: "memory");
        EO_LOAD(2); asm volatile("" ::: "memory"); EO_STORE(0); asm volatile("" ::: "memory");
        EO_LOAD(3); asm volatile("" ::: "memory"); EO_STORE(1); asm volatile("" ::: "memory");
        EO_STORE(2); asm volatile("" ::: "memory"); EO_STORE(3);
#undef EO_LOAD
#undef EO_STORE
    }
};

template <class Epi, class Sched, bool ALIGN_EPI = false, bool SP2 = false, bool I8 = false>
__device__ __forceinline__ void gemm_phase(PG8_LAS unsigned char* lds, const Gemm g, const Sched& S, const Epi& E) {
    int tid_ = threadIdx.x; asm volatile("" : "+v"(tid_));
    const int tid = tid_, wid = __builtin_amdgcn_readfirstlane(tid >> 6), lane = tid & 63, wr = wid >> 2, wc = wid & 3, fr = lane & 15, fq = lane >> 4;
    const int K = g.K, nt = K / BK;
    unsigned voffA[2], voffB[2];
#pragma unroll
    for (int i = 0; i < 2; ++i) { int R, C; stage_rc(tid * 16 + i * 8192, R, C); const int Rb = Epi::PERM ? ((R & ~31) + perm32(R & 31)) : R;
        voffA[i] = (unsigned)(R * K + C) * 2u; voffB[i] = (unsigned)(Rb * K + C) * 2u; }
    const size_t kstep = (size_t)(BK * 2);
    const size_t hstep = (size_t)HALF * K * 2;
    const size_t tstep = 2 * hstep;
    const unsigned ldsw = (unsigned)wid * 1024u;
    const int aoff = lds_byte(wr * 64 + fr, fq * 8), boff = lds_byte(wc * 32 + fr, fq * 8);
#define PG8_SA(b, h) (((b) * 2 + (h)) * HTB)
#define PG8_SB(b, h) ((4 + (b) * 2 + (h)) * HTB)
#define PG8_STAGE(bufoff, gbase, voff) do { _Pragma("unroll") for (int _i = 0; _i < 2; ++_i) \
        __builtin_amdgcn_global_load_lds((const unsigned*)((const char*)(gbase) + (voff)[_i]), (PG8_LAS unsigned*)(lds + (bufoff) + ldsw + _i * 8192), 16, 0, 0); } while (0)
#define PG8_LDA(dst, b, h) do { _Pragma("unroll") for (int m = 0; m < 4; ++m) _Pragma("unroll") for (int k = 0; k < 2; ++k) dst[m][k] = *(const PG8_LAS bf16x8*)(lds + PG8_SA(b, h) + aoff + m * 2048 + k * 1024); } while (0)
#define PG8_LDB(dst, b, h) do { _Pragma("unroll") for (int n = 0; n < 2; ++n) _Pragma("unroll") for (int k = 0; k < 2; ++k) dst[n][k] = *(const PG8_LAS bf16x8*)(lds + PG8_SB(b, h) + boff + n * 2048 + k * 1024); } while (0)
#define PG8_MMA(ai, bj, At, Bt) do { __builtin_amdgcn_s_setprio(1); _Pragma("unroll") for (int m = 0; m < 4; ++m) _Pragma("unroll") for (int n = 0; n < 2; ++n) _Pragma("unroll") for (int k = 0; k < 2; ++k) \
        { if constexpr (I8) acc[ai][bj][m][n] = __builtin_bit_cast(f32x4, __builtin_amdgcn_mfma_i32_16x16x64_i8(__builtin_bit_cast(i32x4, Bt[n][k]), __builtin_bit_cast(i32x4, At[m][k]), __builtin_bit_cast(i32x4, acc[ai][bj][m][n]), 0, 0, 0)); \
          else acc[ai][bj][m][n] = __builtin_amdgcn_mfma_f32_16x16x32_bf16(Bt[n][k], At[m][k], acc[ai][bj][m][n], 0, 0, 0); } __builtin_amdgcn_s_setprio(0); } while (0)
#define PG8_WAIT_V(n) asm volatile("s_waitcnt vmcnt(" #n ")" ::: "memory")
#define PG8_WAIT_L(n) asm volatile("s_waitcnt lgkmcnt(" #n ")" ::: "memory")
#define PG8_BAR __builtin_amdgcn_s_barrier()
#define PG8_SCHED __builtin_amdgcn_sched_barrier(0)
    Unit cur, nxt; int ui = 0;
    if (!S.next(0, cur)) return;
    f32x4 acc[2][2][4][2];
#pragma unroll
    for (int a = 0; a < 2; ++a)
#pragma unroll
        for (int b = 0; b < 2; ++b)
#pragma unroll
            for (int m = 0; m < 4; ++m)
#pragma unroll
                for (int n = 0; n < 2; ++n) acc[a][b][m][n] = (f32x4){0.f, 0.f, 0.f, 0.f};
    bf16x8 At[4][2], B0[2][2], B1[2][2];
    const char* cA = (const char*)g.A + (size_t)cur.pm * tstep; const char* cB = (const char*)g.Bt + (size_t)cur.pn * tstep;
    S.a_ready(cur);
    if constexpr (SP2) {
        PG8_STAGE(PG8_SB(0, 0), cB, voffB); PG8_STAGE(PG8_SB(0, 1), cB + hstep, voffB); PG8_STAGE(PG8_SA(0, 0), cA, voffA); PG8_STAGE(PG8_SA(0, 1), cA + hstep, voffA);
        if (wr == 1) PG8_BAR;
        PG8_WAIT_V(2); PG8_BAR;
        PG8_STAGE(PG8_SB(1, 0), cB + kstep, voffB); PG8_STAGE(PG8_SA(1, 0), cA + kstep, voffA); PG8_STAGE(PG8_SB(1, 1), cB + hstep + kstep, voffB);
        PG8_WAIT_V(6); PG8_BAR;
    } else {
        PG8_STAGE(PG8_SB(0, 0), cB, voffB); PG8_STAGE(PG8_SA(0, 0), cA, voffA); PG8_STAGE(PG8_SB(0, 1), cB + hstep, voffB); PG8_STAGE(PG8_SA(0, 1), cA + hstep, voffA);
        if (wr == 1) PG8_BAR;
        PG8_WAIT_V(4); PG8_BAR;
        PG8_STAGE(PG8_SB(1, 0), cB + kstep, voffB); PG8_STAGE(PG8_SA(1, 0), cA + kstep, voffA); PG8_STAGE(PG8_SB(1, 1), cB + hstep + kstep, voffB);
        PG8_WAIT_V(6); PG8_BAR;
    }
    for (;;) {
        const bool has_next = S.next(ui + 1, nxt);
        const char* nA = has_next ? (const char*)g.A + (size_t)nxt.pm * tstep : cA; const char* nB = has_next ? (const char*)g.Bt + (size_t)nxt.pn * tstep : cB;
        for (int t = 0; t < nt; t += 2) {
            if constexpr (Epi::MIDHOOK) { if (t == (nt >> 1)) E.mid(acc, cur, wr, wc, fr, fq); }
            const bool last = (t == nt - 2);
            const char* a1 = cA + (size_t)(t + 1) * kstep;
            const char* a2 = last ? nA : cA + (size_t)(t + 2) * kstep; const char* b2 = last ? nB : cB + (size_t)(t + 2) * kstep;
            const char* a3 = a2 + kstep; const char* b3 = b2 + kstep;
            if (last && has_next) S.a_ready(nxt);
            if constexpr (SP2) {
            PG8_LDB(B0, 0, 0); PG8_LDB(B1, 0, 1); PG8_SCHED; PG8_LDA(At, 0, 0); PG8_STAGE(PG8_SA(1, 1), a1 + hstep, voffA);
            PG8_WAIT_V(8); PG8_WAIT_L(0); PG8_BAR; PG8_MMA(0, 0, At, B0); PG8_MMA(0, 1, At, B1); PG8_BAR; PG8_SCHED;
            PG8_LDA(At, 0, 1); PG8_STAGE(PG8_SB(0, 0), b2, voffB); PG8_STAGE(PG8_SB(0, 1), b2 + hstep, voffB); PG8_STAGE(PG8_SA(0, 0), a2, voffA);
            PG8_WAIT_V(8); PG8_WAIT_L(0); PG8_BAR; PG8_MMA(1, 0, At, B0); PG8_MMA(1, 1, At, B1); PG8_BAR; PG8_SCHED;
            PG8_LDB(B0, 1, 0); PG8_LDB(B1, 1, 1); PG8_SCHED; PG8_LDA(At, 1, 0); PG8_STAGE(PG8_SA(0, 1), a2 + hstep, voffA);
            PG8_WAIT_V(8); PG8_WAIT_L(0); PG8_BAR; PG8_MMA(0, 0, At, B0); PG8_MMA(0, 1, At, B1); PG8_BAR; PG8_SCHED;
            PG8_LDA(At, 1, 1); PG8_STAGE(PG8_SB(1, 0), b3, voffB); PG8_STAGE(PG8_SB(1, 1), b3 + hstep, voffB); PG8_STAGE(PG8_SA(1, 0), a3, voffA);
            PG8_WAIT_V(8); PG8_WAIT_L(0); PG8_BAR; PG8_MMA(1, 0, At, B0); PG8_MMA(1, 1, At, B1); PG8_BAR; PG8_SCHED;
            } else {
            PG8_LDB(B0, 0, 0); PG8_SCHED; PG8_LDA(At, 0, 0); PG8_STAGE(PG8_SA(1, 1), a1 + hstep, voffA);
            PG8_WAIT_L(8); PG8_BAR; PG8_WAIT_L(0); PG8_MMA(0, 0, At, B0); PG8_BAR; PG8_SCHED;
            PG8_LDB(B1, 0, 1); PG8_STAGE(PG8_SB(0, 0), b2, voffB);
            PG8_BAR; PG8_WAIT_L(0); PG8_MMA(0, 1, At, B1); PG8_BAR;
            PG8_LDA(At, 0, 1); PG8_STAGE(PG8_SA(0, 0), a2, voffA);
            PG8_BAR; PG8_WAIT_L(0); PG8_MMA(1, 0, At, B0); PG8_BAR; PG8_SCHED;
            PG8_STAGE(PG8_SB(0, 1), b2 + hstep, voffB);
            PG8_WAIT_V(6); PG8_BAR; PG8_MMA(1, 1, At, B1); PG8_BAR;
            PG8_LDB(B0, 1, 0); PG8_SCHED; PG8_LDA(At, 1, 0); PG8_STAGE(PG8_SA(0, 1), a2 + hstep, voffA);
            PG8_WAIT_L(8); PG8_BAR; PG8_WAIT_L(0); PG8_MMA(0, 0, At, B0); PG8_BAR; PG8_SCHED;
            PG8_LDB(B1, 1, 1); PG8_STAGE(PG8_SB(1, 0), b3, voffB);
            PG8_BAR; PG8_WAIT_L(0); PG8_MMA(0, 1, At, B1); PG8_BAR;
            PG8_LDA(At, 1, 1); PG8_STAGE(PG8_SA(1, 0), a3, voffA);
            PG8_BAR; PG8_WAIT_L(0); PG8_MMA(1, 0, At, B0); PG8_BAR; PG8_SCHED;
            PG8_STAGE(PG8_SB(1, 1), b3 + hstep, voffB);
            PG8_WAIT_V(6); PG8_BAR; PG8_MMA(1, 1, At, B1); PG8_BAR;
            }
        }
        if constexpr (ALIGN_EPI) { if (wr == 0) PG8_BAR; }
        if constexpr (I8) {
#pragma unroll
            for (int a = 0; a < 2; ++a)
#pragma unroll
                for (int b = 0; b < 2; ++b)
#pragma unroll
                    for (int m = 0; m < 4; ++m)
#pragma unroll
                        for (int n = 0; n < 2; ++n)
#pragma unroll
                            for (int j = 0; j < 4; ++j) acc[a][b][m][n][j] = (float)__float_as_int(acc[a][b][m][n][j]);
        }
        if constexpr (!Epi::AFTER_DRAIN) { E(acc, cur, wr, wc, fr, fq); S.done(cur); }
        if (!has_next) break;
#pragma unroll
        for (int a = 0; a < 2; ++a)
#pragma unroll
            for (int b = 0; b < 2; ++b)
#pragma unroll
                for (int m = 0; m < 4; ++m)
#pragma unroll
                    for (int n = 0; n < 2; ++n) acc[a][b][m][n] = (f32x4){0.f, 0.f, 0.f, 0.f};
        cur = nxt; cA = nA; cB = nB; ++ui;
        if constexpr (ALIGN_EPI) { if (wr == 1) PG8_BAR; }
    }
    PG8_WAIT_V(0);
    if constexpr (!ALIGN_EPI) { if (wr == 0) PG8_BAR; }
    PG8_BAR;
    if constexpr (Epi::AFTER_DRAIN) { E.fused(acc, cur, wr, wc, fr, fq, lds, wid, lane); S.done(cur); }
#undef PG8_SA
#undef PG8_SB
#undef PG8_STAGE
#undef PG8_LDA
#undef PG8_LDB
#undef PG8_MMA
#undef PG8_WAIT_V
#undef PG8_WAIT_L
#undef PG8_BAR
#undef PG8_SCHED
}
}
namespace att {
typedef unsigned short u16;
typedef short bf16x8 __attribute__((ext_vector_type(8)));
typedef short s16x4 __attribute__((ext_vector_type(4)));
typedef float f32x16 __attribute__((ext_vector_type(16)));
typedef float f32x4 __attribute__((ext_vector_type(4)));
typedef unsigned u32x4 __attribute__((ext_vector_type(4)));
constexpr int D = 128, NW = 8, QBLK = 32, KVBLK = 64, QB = NW * QBLK;
constexpr int SHM_V = KVBLK * D * 2, SHM_K = KVBLK * D * 2;
constexpr int OFF_WS = 2 * SHM_V + 2 * SHM_K, OFF_KM = OFF_WS + NW * 64 * 4, ATT_LDS = OFF_KM + 8192;
constexpr float SCALE = 0.08838834764831845f, THR = 8.f;
#define KSWZ(row, colB) ((row) * 256 + ((colB) ^ (((row) & 7) << 4)))
#define SBAR() __builtin_amdgcn_sched_barrier(0)
__device__ __forceinline__ int v_st(int k, int c) { const int kk = (k & ~0xC) | ((k & 4) << 1) | ((k & 8) >> 1); return ((kk >> 3) * 4 + (c >> 5)) * 512 + ((kk & 7) * 32 + (c & 31)) * 2; }
__device__ __forceinline__ int v_rd_base(int lane) { return ((lane & 3) << 3) | (((lane >> 2) & 3) << 6) | (((lane >> 4) & 1) << 5) | (((lane >> 5) & 1) << 8); }
constexpr int v_rd_off(int d0, int ks, int half) { return d0 * 512 + ks * 4096 + half * 2048; }
__device__ __forceinline__ int crow(int r, int hi) { return (r & 3) + 8 * (r >> 2) + 4 * hi; }
__device__ __forceinline__ unsigned cvtpk(float lo, float hi) { unsigned r; asm volatile("v_cvt_pk_bf16_f32 %0, %1, %2" : "=v"(r) : "v"(lo), "v"(hi)); return r; }
__device__ __forceinline__ bf16x8 pack8(f32x4 a, f32x4 b) { u32x4 w = {cvtpk(a[0], a[1]), cvtpk(a[2], a[3]), cvtpk(b[0], b[1]), cvtpk(b[2], b[3])}; return *reinterpret_cast<bf16x8*>(&w); }
__device__ __forceinline__ bf16x8 load8(const u16* p) { return *reinterpret_cast<const bf16x8*>(p); }
__device__ __forceinline__ bf16x8 ldg8(const u16* ubase, unsigned voff) { return *reinterpret_cast<const bf16x8*>((const char*)ubase + voff); }
__device__ __forceinline__ void mask_tile(f32x16& p0, f32x16& p1, int dq) {
    const float NEG = -__builtin_inff();
#pragma unroll
    for (int r = 0; r < 16; ++r) { const int c = (r & 3) + 8 * (r >> 2); if (dq - c < 0) p0[r] = NEG; if (dq - c - 32 < 0) p1[r] = NEG; }
}
__device__ __forceinline__ void partialSM(f32x16& p0, f32x16& p1, float& m_reg, float& mn, float& alpha, bool off) {
    float pmax = p0[0];
#pragma unroll
    for (int r = 1; r < 16; ++r) pmax = fmaxf(pmax, p0[r]);
#pragma unroll
    for (int r = 0; r < 16; ++r) pmax = fmaxf(pmax, p1[r]);
    { auto rr = __builtin_amdgcn_permlane32_swap(__float_as_uint(pmax), __float_as_uint(pmax), false, false);
      pmax = fmaxf(__uint_as_float(rr[0]), __uint_as_float(rr[1])); }
    if (off) pmax = -__builtin_inff();
    constexpr float C2 = 1.4426950408889634f * SCALE;
    if (__builtin_expect(__all((pmax - m_reg) * SCALE <= THR), 1)) { mn = m_reg; alpha = 1.f; }
    else { mn = fmaxf(m_reg, pmax); alpha = __builtin_amdgcn_exp2f((m_reg - mn) * C2); m_reg = mn; }
    float mnL = -mn * C2; if (off) mnL = -__builtin_inff();
#pragma unroll
    for (int r = 0; r < 16; ++r) p0[r] = fmaf(p0[r], C2, mnL);
#pragma unroll
    for (int r = 0; r < 16; ++r) p1[r] = fmaf(p1[r], C2, mnL);
#pragma unroll
    for (int r = 0; r < 16; ++r) p0[r] = __builtin_amdgcn_exp2f(p0[r]);
}
__device__ __forceinline__ void finishSM(f32x16& p0, f32x16& p1, float alpha, float& l_reg, bf16x8& pa0, bf16x8& pa1, bf16x8& pa2, bf16x8& pa3) {
#pragma unroll
    for (int r = 0; r < 16; ++r) p1[r] = __builtin_amdgcn_exp2f(p1[r]);
    float ps = 0;
#pragma unroll
    for (int r = 0; r < 16; ++r) ps += p0[r];
#pragma unroll
    for (int r = 0; r < 16; ++r) ps += p1[r];
    { auto rr = __builtin_amdgcn_permlane32_swap(__float_as_uint(ps), __float_as_uint(ps), false, false);
      ps = __uint_as_float(rr[0]) + __uint_as_float(rr[1]); }
    l_reg = l_reg * alpha + ps;
#define PK4(P, B_, OUT) do { unsigned a0 = cvtpk(P[B_+0], P[B_+1]), a1 = cvtpk(P[B_+2], P[B_+3]);                          \
        unsigned b0 = cvtpk(P[B_+4], P[B_+5]), b1 = cvtpk(P[B_+6], P[B_+7]);                                             \
        auto r0 = __builtin_amdgcn_permlane32_swap(a0, b0, false, false); auto r1 = __builtin_amdgcn_permlane32_swap(a1, b1, false, false); \
        u32x4 w = {r0[0], r1[0], r0[1], r1[1]}; OUT = *reinterpret_cast<bf16x8*>(&w); } while (0)
    PK4(p0, 0, pa0); PK4(p0, 8, pa1); PK4(p1, 0, pa2); PK4(p1, 8, pa3);
#undef PK4
}
template <int KB>
__device__ __forceinline__ void qkt(f32x16& p0, f32x16& p1, const char* K_lds, int r32, int hi, const bf16x8* qr) {
    p0 = f32x16{}; p1 = f32x16{};
    const char* kb[4];
#pragma unroll
    for (int dd = 0; dd < 4; ++dd) kb[dd] = K_lds + KB * SHM_K + KSWZ(r32, (dd * 16 + hi * 8) * 2);
#pragma unroll
    for (int d0 = 0; d0 < 8; ++d0) { const char* a = kb[d0 & 3] + (d0 >> 2) * 128;
        bf16x8 b0 = *reinterpret_cast<const bf16x8*>(a);
        bf16x8 b1 = *reinterpret_cast<const bf16x8*>(a + 32 * 256);
        p0 = __builtin_amdgcn_mfma_f32_32x32x16_bf16(b0, qr[d0], p0, 0, 0, 0);
        p1 = __builtin_amdgcn_mfma_f32_32x32x16_bf16(b1, qr[d0], p1, 0, 0, 0); }
}
template <int VB>
__device__ __forceinline__ void pv_tile(f32x16* o, int vb0, bf16x8 pa0, bf16x8 pa1, bf16x8 pa2, bf16x8 pa3) {
#define TRRD(dst, off) asm volatile("ds_read_b64_tr_b16 %0, %1 offset:%2" : "=&v"(dst) : "v"(vb0), "i"(off) : "memory")
#define PV_D0(d0) do { s16x4 l0, l1, l2, l3, h0, h1, h2, h3; constexpr int b_ = VB * SHM_V + v_rd_off(d0, 0, 0); \
        TRRD(l0, b_); TRRD(h0, b_ + 2048); TRRD(l1, b_ + 4096); TRRD(h1, b_ + 6144); TRRD(l2, b_ + 8192); TRRD(h2, b_ + 10240); TRRD(l3, b_ + 12288); TRRD(h3, b_ + 14336); \
        asm volatile("s_waitcnt lgkmcnt(0)" ::: "memory"); SBAR();   \
        o[d0] = __builtin_amdgcn_mfma_f32_32x32x16_bf16(pa0, (bf16x8){l0[0], l0[1], l0[2], l0[3], h0[0], h0[1], h0[2], h0[3]}, o[d0], 0, 0, 0);   \
        o[d0] = __builtin_amdgcn_mfma_f32_32x32x16_bf16(pa1, (bf16x8){l1[0], l1[1], l1[2], l1[3], h1[0], h1[1], h1[2], h1[3]}, o[d0], 0, 0, 0);   \
        o[d0] = __builtin_amdgcn_mfma_f32_32x32x16_bf16(pa2, (bf16x8){l2[0], l2[1], l2[2], l2[3], h2[0], h2[1], h2[2], h2[3]}, o[d0], 0, 0, 0);   \
        o[d0] = __builtin_amdgcn_mfma_f32_32x32x16_bf16(pa3, (bf16x8){l3[0], l3[1], l3[2], l3[3], h3[0], h3[1], h3[2], h3[3]}, o[d0], 0, 0, 0); } while (0)
    PV_D0(0); PV_D0(1); PV_D0(2); PV_D0(3);
#undef PV_D0
#undef TRRD
}
struct BlockRef { const u16* Q; const u16* K; const u16* V; const u16* Z; u16* O; const float* KM; int qb; };
struct Seam { bf16x8 qr[8]; bf16x8 st_v0, st_v1, st_k0, st_k1; };
#define ROW(p, k0, rr) ((p) + (size_t)((k0) + (rr)) * LDP + sc)
#define VMW() asm volatile("s_waitcnt vmcnt(0)" ::: "memory")
#define VMWN(n) asm volatile("s_waitcnt vmcnt(%0)" :: "i"(n) : "memory")
#define SLOAD_H(Kp, Vp, k0) do { const u16* vt_ = (Vp) + (size_t)(k0) * LDP; const u16* kt_ = (Kp) + (size_t)(k0) * LDP;            \
                         S.st_v0 = ldg8(vt_, roff); S.st_v1 = ldg8(vt_ + 32 * LDP, roff); S.st_k0 = ldg8(kt_, roff); S.st_k1 = ldg8(kt_ + 32 * LDP, roff); } while (0)
#define SWRITE_HK(bf) do { *(bf16x8*)(K_lds + (bf) * SHM_K + kws) = S.st_k0; *(bf16x8*)(K_lds + (bf) * SHM_K + kws + 32 * 256) = S.st_k1; } while (0)
#define SWRITE_HV(bf) do { *(bf16x8*)(V_lds + (bf) * SHM_V + vst0) = S.st_v0; *(bf16x8*)(V_lds + (bf) * SHM_V + vst1) = S.st_v1; } while (0)
#define SWRITE_H(bf) do { SWRITE_HV(bf); SWRITE_HK(bf); } while (0)
__device__ __forceinline__ void moba_prime(const BlockRef& cur, char* lds, Seam& S) {
    const int tid = threadIdx.x, wid = __builtin_amdgcn_readfirstlane(tid >> 6), lane = tid & 63, r32 = lane & 31, hi = lane >> 5;
    const int sr = tid >> 4, sc = (tid & 15) * 8, kws = KSWZ(sr, sc * 2); char* K_lds = lds + 2 * SHM_V;
    const unsigned roff = (unsigned)(sr * LDP + sc) * 2u, qoff = (unsigned)((wid * QBLK + r32) * LDP + hi * 8) * 2u;
#pragma unroll
    for (int d0 = 0; d0 < 8; ++d0) S.qr[d0] = ldg8(cur.Q + d0 * 16, qoff);
    SLOAD_H(cur.K, cur.V, 0); VMW(); SWRITE_HK(0);
    __syncthreads();
}
__device__ __forceinline__ void moba_block(const BlockRef& cur, const BlockRef& nxt, char* lds, Seam& S) {
    int tid_ = threadIdx.x; asm volatile("" : "+v"(tid_));
    const int tid = tid_, wid = __builtin_amdgcn_readfirstlane(tid >> 6), lane = tid & 63, r32 = lane & 31, hi = lane >> 5;
    const int NT = 4 * (cur.qb + 1), P0 = cur.qb * QB;
    const int qlo = P0 + wid * QBLK, qm = qlo + r32 - 4 * hi;
    char* V_lds = lds; char* K_lds = lds + 2 * SHM_V;
    float* ws = (float*)(lds + OFF_WS) + wid * 64; float* li_l = ws, * al_l = ws + 32;
    float m_reg = -1e30f, l_reg = 0; f32x16 o[4] = {};
    const int sr = tid >> 4, sc = (tid & 15) * 8, vst0 = v_st(sr, sc), vst1 = v_st(32 + sr, sc), kws = KSWZ(sr, sc * 2);
    const int vb0 = (int)(uintptr_t)V_lds + v_rd_base(lane);
    const unsigned roff = (unsigned)(sr * LDP + sc) * 2u, qoff = (unsigned)((wid * QBLK + r32) * LDP + hi * 8) * 2u;
    const u16* Kh = cur.K; const u16* Vh = cur.V;
    unsigned sel = 0xffffu;
    if (cur.qb > 3) {
        char* KMT = lds + OFF_KM;
        { const int row = tid >> 4, c = tid & 15, j = row & 15;
          const float* kp = cur.KM + (size_t)j * 2048 + c * 8;
          const f32x4 a0 = *(const f32x4*)kp, a1 = *(const f32x4*)(kp + 4), b0 = *(const f32x4*)(kp + 128), b1 = *(const f32x4*)(kp + 132);
          const f32x4 x0 = (a0 + b0) * (1.0f / 256.0f), x1 = (a1 + b1) * (1.0f / 256.0f);
          const bf16x8 hv = pack8(x0, x1);
          f32x4 y0, y1;
#pragma unroll
          for (int i = 0; i < 4; ++i) { y0[i] = x0[i] - __uint_as_float(((unsigned)(unsigned short)hv[i]) << 16); y1[i] = x1[i] - __uint_as_float(((unsigned)(unsigned short)hv[4 + i]) << 16); }
          const bf16x8 lv = pack8(y0, y1);
          *(bf16x8*)(KMT + KSWZ(row, c * 16)) = (row >> 4) ? lv : hv; }
        __syncthreads();
        f32x16 g = f32x16{};
#pragma unroll
        for (int d0 = 0; d0 < 8; ++d0) { const bf16x8 a = *reinterpret_cast<const bf16x8*>(KMT + KSWZ(r32, (d0 * 16 + hi * 8) * 2));
            g = __builtin_amdgcn_mfma_f32_32x32x16_bf16(a, S.qr[d0], g, 0, 0, 0); }
        float G[16];
#pragma unroll
        for (int r = 0; r < 8; ++r) { const float gv = g[r] + g[r + 8];
            auto rr = __builtin_amdgcn_permlane32_swap(__float_as_uint(gv), __float_as_uint(gv), false, false);
            G[(r & 3) + 8 * (r >> 2)] = __uint_as_float(rr[0]); G[(r & 3) + 8 * (r >> 2) + 4] = __uint_as_float(rr[1]); }
        sel = 1u << cur.qb;
#pragma unroll
        for (int k = 0; k < 3; ++k) { float best = -__builtin_inff(); int bi = 0;
#pragma unroll
            for (int j = 0; j < 16; ++j) { const float v = (j < cur.qb && !((sel >> j) & 1u)) ? G[j] : -__builtin_inff(); if (v > best) { best = v; bi = j; } }
            sel |= 1u << bi; }
    }
#define OFF(t) (!((sel >> ((t) >> 2)) & 1u))
#define RESC(a) do { if (__any((a) < 1.f)) { if (hi == 0) al_l[r32] = (a); asm volatile("s_waitcnt lgkmcnt(0)" ::: "memory");              \
                     for (int d_ = 0; d_ < 4; ++d_) for (int r = 0; r < 16; ++r) o[d_][r] *= al_l[crow(r, hi)]; } } while (0)
#define KBASE(t) ((t) * KVBLK)
#define MASKT(P0_, P1_, t) do { const int kb_ = KBASE(t); if (kb_ + KVBLK - 1 > qlo) mask_tile(P0_, P1_, qm - kb_); } while (0)
#define SEAM_K0() do { VMWN(8); SWRITE_HK(0); SBAR(); } while (0)
    f32x16 pA0, pA1, pB0, pB1; float mnA, mnB, alA, alB; bf16x8 pa0, pa1, pa2, pa3;
    SWRITE_HV(0); SBAR();
    if (NT > 1) SLOAD_H(Kh, Vh, KBASE(1));
    SBAR(); qkt<0>(pA0, pA1, K_lds, r32, hi, S.qr);
    MASKT(pA0, pA1, 0); partialSM(pA0, pA1, m_reg, mnA, alA, OFF(0));
    if (NT > 1) { VMW(); SWRITE_H(1); }
    __syncthreads();
#define HALF_STEP(PX0, PX1, mnX, alX, PY0, PY1, alY, t, KB, VB, SB) do {                                                      \
        SBAR(); qkt<KB>(PX0, PX1, K_lds, r32, hi, S.qr);                                                                      \
        finishSM(PY0, PY1, alY, l_reg, pa0, pa1, pa2, pa3); SBAR();                                                           \
        if ((t) + 1 < NT) { SLOAD_H(Kh, Vh, KBASE((t) + 1)); SBAR(); }                                                        \
        pv_tile<VB>(o, vb0, pa0, pa1, pa2, pa3); MASKT(PX0, PX1, (t)); partialSM(PX0, PX1, m_reg, mnX, alX, OFF(t));           \
        __syncthreads();                                                                                                      \
        if ((t) + 1 < NT) { VMW(); SWRITE_H(SB); }                                                                            \
        RESC(alX); __syncthreads(); } while (0)
    for (int t = 1; t + 1 < NT; t += 2) {
        HALF_STEP(pB0, pB1, mnB, alB, pA0, pA1, alA, t, 1, 0, 0);
        HALF_STEP(pA0, pA1, mnA, alA, pB0, pB1, alB, t + 1, 0, 1, 1);
    }
    const bool even = (NT & 1) == 0;
    if (even) { SBAR(); qkt<1>(pB0, pB1, K_lds, r32, hi, S.qr); SBAR(); }
    SLOAD_H(nxt.K, nxt.V, 0); SBAR();
#pragma unroll
    for (int d0 = 0; d0 < 8; ++d0) S.qr[d0] = ldg8(nxt.Q + d0 * 16, qoff);
    SBAR();
    finishSM(pA0, pA1, alA, l_reg, pa0, pa1, pa2, pa3); SBAR();
    pv_tile<0>(o, vb0, pa0, pa1, pa2, pa3);
    if (even) { MASKT(pB0, pB1, NT - 1); partialSM(pB0, pB1, m_reg, mnB, alB, OFF(NT - 1)); __syncthreads(); RESC(alB);
        finishSM(pB0, pB1, alB, l_reg, pa0, pa1, pa2, pa3); SBAR(); pv_tile<1>(o, vb0, pa0, pa1, pa2, pa3); }
    SBAR(); SEAM_K0();
    if (hi == 0) li_l[r32] = l_reg; asm volatile("s_waitcnt lgkmcnt(0)" ::: "memory");
    float rli[16];
#pragma unroll
    for (int r = 0; r < 16; ++r) rli[r] = __builtin_amdgcn_rcpf(li_l[crow(r, hi)]);
    __syncthreads();
    char* stg = V_lds + wid * 4096;
    const int srow = lane >> 4, schunk = lane & 15;
#pragma unroll
    for (int h = 0; h < 2; ++h) {
        u32x4 zq[4];
#pragma unroll
        for (int k = 0; k < 4; ++k) zq[k] = *(const u32x4*)(cur.Z + (size_t)(wid * QBLK + 16 * h + 4 * k + srow) * LDP + schunk * 8);
#pragma unroll
        for (int rr = 0; rr < 8; ++rr) { const int r = 8 * h + rr, row = (rr & 3) + 8 * (rr >> 2) + 4 * hi;
#pragma unroll
            for (int d0 = 0; d0 < 4; ++d0) { const float v = o[d0][r] * rli[r];
                *(unsigned short*)(stg + (row * 128 + d0 * 32 + r32) * 2) = (unsigned short)(cvtpk(v, v) & 0xffffu); } }
        asm volatile("s_waitcnt lgkmcnt(0)" ::: "memory");
#pragma unroll
        for (int k = 0; k < 4; ++k) { const u32x4 ov = *(const u32x4*)(stg + ((4 * k + srow) * 128 + schunk * 8) * 2); const u32x4 z = zq[k]; u32x4 w;
#define MZ(a, b) cvtpk(__uint_as_float((a) << 16) * __uint_as_float((b) << 16), __uint_as_float((a) & 0xffff0000u) * __uint_as_float((b) & 0xffff0000u))
            w.x = MZ(ov.x, z.x); w.y = MZ(ov.y, z.y); w.z = MZ(ov.z, z.z); w.w = MZ(ov.w, z.w);
#undef MZ
            *(u32x4*)(cur.O + (size_t)(wid * QBLK + 16 * h + 4 * k + srow) * DM + schunk * 8) = w; }
        asm volatile("s_waitcnt lgkmcnt(0)" ::: "memory");
    }
    __syncthreads();
#undef OFF
#undef RESC
#undef KBASE
#undef MASKT
#undef SEAM_K0
#undef HALF_STEP
}
#undef ROW
#undef VMW
#undef VMWN
#undef SLOAD_H
#undef SWRITE_HK
#undef SWRITE_HV
#undef SWRITE_H
}

#define LAS __attribute__((address_space(3)))
typedef unsigned short u16;
typedef float f32x4_t __attribute__((ext_vector_type(4)));
typedef unsigned u32x4_t __attribute__((ext_vector_type(4)));
typedef unsigned u32x2_t __attribute__((ext_vector_type(2)));
typedef short bf16x8_t __attribute__((ext_vector_type(8)));
__device__ __forceinline__ unsigned pk2(float lo, float hi) { return pg8::cvt_pk_bf16(lo, hi); }
__device__ __forceinline__ float wave_sum(float v) {
#pragma unroll
    for (int o = 1; o < 64; o <<= 1) v += __shfl_xor(v, o);
    return v;
}
__device__ __forceinline__ void transpose_item(const float* W, int N, u16* WT, int ldo, int col_off, LAS float* scr, int item, int lane) {
    const int nblk = N / 64, kb = item / nblk, nb = item % nblk, k0 = 64 * kb, n0 = 64 * nb;
    const float* src = W + (size_t)(k0 + (lane >> 4)) * N + n0 + (lane & 15) * 4;
    f32x4_t v[16];
#pragma unroll
    for (int i = 0; i < 16; ++i) v[i] = *(const f32x4_t*)(src + (size_t)(4 * i) * N);
#pragma unroll
    for (int i = 0; i < 16; ++i) *(LAS f32x4_t*)(scr + (4 * i + (lane >> 4)) * 68 + (((lane & 15) * 4 + 4 * (i >> 1)) & 63)) = v[i];
    asm volatile("s_waitcnt lgkmcnt(0)" ::: "memory");
    const int c = lane & 7;
#pragma unroll
    for (int j = 0; j < 8; ++j) { const int n = (lane >> 3) + 8 * j; const LAS float* s = scr + (8 * c) * 68 + ((n + 4 * c) & 63);
        u32x4_t o; o.x = pk2(s[0 * 68], s[1 * 68]); o.y = pk2(s[2 * 68], s[3 * 68]); o.z = pk2(s[4 * 68], s[5 * 68]); o.w = pk2(s[6 * 68], s[7 * 68]);
        *(u32x4_t*)(WT + (size_t)(n0 + n) * ldo + col_off + k0 + 8 * c) = o; }
    asm volatile("s_waitcnt lgkmcnt(0)" ::: "memory");
}
struct Params {
    const float *x, *norm_g, *w_in, *q_g, *k_g, *sgu_g, *w_s, *b_s, *w_a, *w_b, *w_out;
    float* out; unsigned char* ws; int ph_lo, ph_hi;
};
__device__ __forceinline__ unsigned pack_i8x4(float a, float b, float c, float d) {
    const int ia = __float2int_rn(a), ib = __float2int_rn(b), ic = __float2int_rn(c), id = __float2int_rn(d);
    return (unsigned)(ia & 0xff) | ((unsigned)(ib & 0xff) << 8) | ((unsigned)(ic & 0xff) << 16) | ((unsigned)(id & 0xff) << 24);
}
__device__ __forceinline__ void i8_strip(const Params& p, LAS unsigned char* lds, int strip) {
    const int tid = threadIdx.x, lane = tid & 63, wave = __builtin_amdgcn_readfirstlane(tid >> 6), n = lane & 31, kg = lane >> 5;
    const int c8 = strip * 32, gl = c8 - 5120, wcol = (c8 < 4096 ? c8 : (c8 < 5120 ? c8 + 1024   : ((gl & 128) ? C_GB : C_GA) + 128 * (gl >> 8) + (gl & 127)));
    signed char* W8 = (signed char*)(p.ws + WS_W8); float* WSC = (float*)(p.ws + WS_WSC);
    LAS float* mx = (LAS float*)lds;
    const float* src = p.w_in + (size_t)(256 * wave + kg * 16) * LDP + wcol + n;
    float v[8][16]; float m = 0.f;
#pragma unroll
    for (int c = 0; c < 8; ++c)
#pragma unroll
        for (int i = 0; i < 16; ++i) v[c][i] = src[(size_t)(32 * c + i) * LDP];
#pragma unroll
    for (int c = 0; c < 8; ++c)
#pragma unroll
        for (int i = 0; i < 16; ++i) m = fmaxf(m, fabsf(v[c][i]));
    m = fmaxf(m, __shfl_xor(m, 32));
    if (lane < 32) mx[wave * 32 + lane] = m;
    __syncthreads();
    float cm = mx[n];
#pragma unroll
    for (int w = 1; w < 8; ++w) cm = fmaxf(cm, mx[w * 32 + n]);
    cm = fmaxf(cm, 1e-30f);
    const float inv = 127.0f / cm;
    if (wave == 0 && lane < 32) WSC[c8 + lane] = cm * (1.0f / 127.0f);
    signed char* dst = W8 + (size_t)(c8 + n) * DM + 256 * wave + kg * 16;
#pragma unroll
    for (int c = 0; c < 8; ++c) {
        u32x4_t o; o.x = pack_i8x4(v[c][0] * inv, v[c][1] * inv, v[c][2] * inv, v[c][3] * inv); o.y = pack_i8x4(v[c][4] * inv, v[c][5] * inv, v[c][6] * inv, v[c][7] * inv);
        o.z = pack_i8x4(v[c][8] * inv, v[c][9] * inv, v[c][10] * inv, v[c][11] * inv); o.w = pack_i8x4(v[c][12] * inv, v[c][13] * inv, v[c][14] * inv, v[c][15] * inv);
        *(u32x4_t*)(dst + 32 * c) = o; }
    __syncthreads();
}
__device__ __forceinline__ void phase_prep(const Params& p, LAS unsigned char* lds, int G) {
    const int tid = threadIdx.x, lane = tid & 63, wave = __builtin_amdgcn_readfirstlane(tid >> 6);
    for (int st = blockIdx.x; st < NI8_TILES * 8; st += G) i8_strip(p, lds, st);
    LAS float* scr = (LAS float*)(lds + wave * 17408);
    const int gw = blockIdx.x * 8 + wave, NGW = G * 8;
    u16* Bt1 = (u16*)(p.ws + WS_BT1); u16* Bt3 = (u16*)(p.ws + WS_BT3); u16* Bt4 = (u16*)(p.ws + WS_BT4);
    constexpr int NBFC = NBF_TILES * 256, I_IN = (DM / 64) * (NBFC / 64), I_A = (1024 / 64) * (DM / 64), I_O = (DM / 64) * (DM / 64), NITEMS = I_IN + 2 * I_A + I_O;
    for (int it = NGW - 1 - gw; it < NITEMS; it += NGW) {
        int r = it;
        if (r < I_IN) { const int kb = r / (NBFC / 64), nb = r % (NBFC / 64);
            transpose_item(p.w_in + 4096 + (nb >= 16 ? 1024 : 0), LDP, Bt1, DM, 0, scr, kb * (LDP / 64) + nb, lane); continue; } r -= I_IN;
        if (r < I_A) { transpose_item(p.w_a, DM, Bt3, DM, 0, scr, r, lane); continue; } r -= I_A;
        if (r < I_A) { transpose_item(p.w_b, DM, Bt3, DM, 1024, scr, r, lane); continue; } r -= I_A;
        transpose_item(p.w_out, DM, Bt4, DM, 0, scr, r, lane);
    }
    u16* H = (u16*)p.out;
    unsigned* H8 = (unsigned*)(p.ws + WS_H8); float* HSC = (float*)(p.ws + WS_HSC);
    const f32x4_t* gr = (const f32x4_t*)p.norm_g + lane;
    f32x4_t nx[8];
    if (gw < TOK) { const f32x4_t* xr = (const f32x4_t*)(p.x + (size_t)gw * DM) + lane;
#pragma unroll
        for (int j = 0; j < 8; ++j) nx[j] = xr[64 * j]; }
    for (int m = gw; m < TOK; m += NGW) {
        f32x4_t v[8]; float s0 = 0.f;
#pragma unroll
        for (int j = 0; j < 8; ++j) v[j] = nx[j];
        if (m + NGW < TOK) { const f32x4_t* xr = (const f32x4_t*)(p.x + (size_t)(m + NGW) * DM) + lane;
#pragma unroll
            for (int j = 0; j < 8; ++j) nx[j] = xr[64 * j]; }
#pragma unroll
        for (int j = 0; j < 8; ++j) s0 += (v[j].x * v[j].x + v[j].y * v[j].y) + (v[j].z * v[j].z + v[j].w * v[j].w);
        const float r0 = __builtin_amdgcn_rsqf(wave_sum(s0) * (1.0f / DM) + EPS);
        float mxv = 0.f;
#pragma unroll
        for (int j = 0; j < 8; ++j) { const f32x4_t g = gr[64 * j]; v[j] = v[j] * r0 * g; mxv = fmaxf(fmaxf(mxv, fmaxf(fabsf(v[j].x), fabsf(v[j].y))), fmaxf(fabsf(v[j].z), fabsf(v[j].w))); }
#pragma unroll
        for (int o = 1; o < 64; o <<= 1) mxv = fmaxf(mxv, __shfl_xor(mxv, o));
        mxv = fmaxf(mxv, 1e-30f); const float inv = 127.0f / mxv;
        if (lane == 0) HSC[m] = mxv * (1.0f / 127.0f);
        u32x2_t* o8 = (u32x2_t*)(H + (size_t)m * DM) + lane; unsigned* q8 = H8 + (size_t)m * (DM / 4) + lane;
#pragma unroll
        for (int j = 0; j < 8; ++j) { u32x2_t w; w.x = pk2(v[j].x, v[j].y); w.y = pk2(v[j].z, v[j].w); o8[64 * j] = w;
            q8[64 * j] = pack_i8x4(v[j].x * inv, v[j].y * inv, v[j].z * inv, v[j].w * inv); }
    }
}
struct SguRegs { u32x4_t vw[4]; f32x4_t w0[4], w1[4]; u32x2_t uu[8], zz[8]; float bias; };
__device__ __forceinline__ void sgu_load(const Params& p, int item, SguRegs& R) {
    const int tid = threadIdx.x, lane = tid & 63, wid = __builtin_amdgcn_readfirstlane(tid >> 6), fr = lane & 15, fq = lane >> 4;
    const int g = item & 7; const size_t tok0 = (size_t)(item >> 3) * 128; const int t = 16 * wid + fr;
    const u16* P = (const u16*)(p.ws + WS_PROJ);
#pragma unroll
    for (int ps = 0; ps < 4; ++ps) { const int s = (tid >> 6) * 16 + ((tid & 63) >> 2), cc = 4 * ps + (tid & 3);     R.vw[ps] = *(const u32x4_t*)(P + (tok0 + s) * LDP + C_VB + g * 128 + cc * 8); }
    const float* Wr = p.w_s + ((size_t)g * 128 + t) * 128 + 8 * fq;
#pragma unroll
    for (int ks = 0; ks < 4; ++ks) { if (32 * ks <= 16 * wid + 15) { R.w0[ks] = *(const f32x4_t*)(Wr + 32 * ks); R.w1[ks] = *(const f32x4_t*)(Wr + 32 * ks + 4); } else { R.w0[ks] = (f32x4_t){0.f, 0.f, 0.f, 0.f}; R.w1[ks] = R.w0[ks]; } }
    const u16* up = P + (tok0 + t) * LDP + C_UB + g * 128 + 8 * fq; const u16* zp = P + (tok0 + t) * LDP + C_ZB + g * 128 + 8 * fq;
#pragma unroll
    for (int cp = 0; cp < 4; ++cp) { const u32x4_t a = *(const u32x4_t*)(up + 32 * cp), b = *(const u32x4_t*)(zp + 32 * cp);
        R.uu[2 * cp] = (u32x2_t){a.x, a.y}; R.uu[2 * cp + 1] = (u32x2_t){a.z, a.w}; R.zz[2 * cp] = (u32x2_t){b.x, b.y}; R.zz[2 * cp + 1] = (u32x2_t){b.z, b.w}; }
    R.bias = p.b_s[g * 128 + t];
}
__device__ __forceinline__ void sgu_stage(LAS u16* vgT, const SguRegs& R) {
    const int tid = threadIdx.x;
#pragma unroll
    for (int ps = 0; ps < 4; ++ps) { const int s = (tid >> 6) * 16 + ((tid & 63) >> 2), cc = 4 * ps + (tid & 3);     const u32x4_t w = R.vw[ps];
        LAS u16* d = vgT + (cc * 8) * 136 + s;
        d[0 * 136] = (u16)(w.x & 0xffffu); d[1 * 136] = (u16)(w.x >> 16); d[2 * 136] = (u16)(w.y & 0xffffu); d[3 * 136] = (u16)(w.y >> 16);
        d[4 * 136] = (u16)(w.z & 0xffffu); d[5 * 136] = (u16)(w.z >> 16); d[6 * 136] = (u16)(w.w & 0xffffu); d[7 * 136] = (u16)(w.w >> 16); }
}
__device__ __forceinline__ void sgu_compute(const Params& p, const LAS u16* vgT, int item, const SguRegs& R) {
    const int tid = threadIdx.x, lane = tid & 63, wid = __builtin_amdgcn_readfirstlane(tid >> 6), fr = lane & 15, fq = lane >> 4;
    const int g = item & 7; const size_t tok0 = (size_t)(item >> 3) * 128; const int t = 16 * wid + fr;
    u16* AB = (u16*)p.out;
    f32x4_t acc[8];
#pragma unroll
    for (int ct = 0; ct < 8; ++ct) acc[ct] = (f32x4_t){0.f, 0.f, 0.f, 0.f};
#pragma unroll
    for (int ks = 0; ks < 4; ++ks) {
        if (32 * ks <= 16 * wid + 15) {
            const int s0 = 32 * ks + 8 * fq; f32x4_t a0 = R.w0[ks], a1 = R.w1[ks];
#pragma unroll
            for (int i = 0; i < 4; ++i) { if (s0 + i > t) a0[i] = 0.f; if (s0 + 4 + i > t) a1[i] = 0.f; }
            u32x4_t aw; aw.x = pk2(a0[0], a0[1]); aw.y = pk2(a0[2], a0[3]); aw.z = pk2(a1[0], a1[1]); aw.w = pk2(a1[2], a1[3]);
            const bf16x8_t a = *reinterpret_cast<bf16x8_t*>(&aw);
#pragma unroll
            for (int ct = 0; ct < 8; ++ct) { const bf16x8_t b = *(const LAS bf16x8_t*)(vgT + (32 * (ct >> 1) + 8 * (fr >> 2) + 4 * (ct & 1) + (fr & 3)) * 136 + s0);
                acc[ct] = __builtin_amdgcn_mfma_f32_16x16x32_bf16(b, a, acc[ct], 0, 0, 0); }
        }
    }
    u16* op = AB + (tok0 + t) * DM + 1024 + g * 128 + 8 * fq;
#pragma unroll
    for (int cp = 0; cp < 4; ++cp) { u32x4_t w4;
#pragma unroll
        for (int h = 0; h < 2; ++h) { const int ct = 2 * cp + h; const f32x4_t m = acc[ct] + R.bias;
            const unsigned lo = pk2(m[0] * pg8::bf_lo(R.uu[ct].x) * pg8::bf_lo(R.zz[ct].x), m[1] * pg8::bf_hi(R.uu[ct].x) * pg8::bf_hi(R.zz[ct].x));
            const unsigned hi = pk2(m[2] * pg8::bf_lo(R.uu[ct].y) * pg8::bf_lo(R.zz[ct].y), m[3] * pg8::bf_hi(R.uu[ct].y) * pg8::bf_hi(R.zz[ct].y));
            if (h == 0) { w4.x = lo; w4.y = hi; } else { w4.z = lo; w4.w = hi; } }
        *(u32x4_t*)(op + 32 * cp) = w4; }
}
__device__ __forceinline__ void sgu_phase(const Params& p, LAS unsigned char* lds, int first, int step, int nitems) {
    int it = first; if (it >= nitems) return;
    SguRegs A; sgu_load(p, it & 1023, A); int par = 0;
    for (;;) {
        LAS u16* vgT = (LAS u16*)(lds + par * 36864);
        sgu_stage(vgT, A);
        const int nx = it + step; const bool has = nx < nitems;
        SguRegs B; if (has) sgu_load(p, nx & 1023, B);
        __syncthreads();
        sgu_compute(p, vgT, it & 1023, A);
        if (!has) break;
        A = B; it = nx; par ^= 1;
    }
    __syncthreads();
}

#define XB_TMO      128
#define XB_XCNT(j)  (256  + 64 * (j))
#define XB_XSUB(j)  (1280 + 64 * (j))
#define XB_XGEN(j)  (2304 + 64 * (j))
#define XB_TOP      3328
#define XB_TOPGEN   3392
#define XCD_BAR_WORDS 3456
#define XB_SPIN_CAP (1u << 18)

__device__ __forceinline__ unsigned xb_ld(unsigned* p)              { return __hip_atomic_load(p, __ATOMIC_RELAXED, __HIP_MEMORY_SCOPE_AGENT); }
__device__ __forceinline__ unsigned xb_add(unsigned* p, unsigned v) { return __hip_atomic_fetch_add(p, v, __ATOMIC_RELAXED, __HIP_MEMORY_SCOPE_AGENT); }
__device__ __forceinline__ unsigned xb_xcc_id() { return (unsigned)__builtin_amdgcn_s_getreg((3 << 11) | 20) & 0xFu; }
#define XB_SPIN(cond, bar) do { unsigned _sp = 0; while (cond) { __builtin_amdgcn_s_sleep(1); \
    if ((++_sp & 255u) == 0u) { if (xb_ld(&(bar)[XB_TMO])) break; if (_sp > XB_SPIN_CAP) { atomicAdd(&(bar)[XB_TMO], 1u); break; } } } } while (0)

struct XcdBarrier {
    unsigned* bar; unsigned x;
    volatile LAS unsigned* st;
};

__device__ __forceinline__ XcdBarrier xcd_barrier_post(unsigned* bar, volatile LAS unsigned* st) {
    XcdBarrier b; b.bar = bar; b.x = xb_xcc_id(); b.st = st;
    if (threadIdx.x == 0) (void)xb_add(&bar[XB_XCNT(b.x)], 1u);
    return b;
}
__device__ __forceinline__ void xcd_barrier_complete(unsigned* bar, unsigned x, unsigned& nloc, unsigned& nx) {
    const unsigned G = gridDim.x * gridDim.y * gridDim.z;
    unsigned sum, cnt, mine, sp = 0u;
    for (;;) {
        sum = 0u; cnt = 0u; mine = 0u;
#pragma unroll
        for (unsigned j = 0; j < 16; ++j) { const unsigned c = xb_ld(&bar[XB_XCNT(j)]); sum += c; cnt += (c > 0u) ? 1u : 0u; mine = (j == x) ? c : mine; }
        if (sum == G) break;
        __builtin_amdgcn_s_sleep(1);
        if ((++sp & 255u) == 0u) { if (xb_ld(&bar[XB_TMO])) break; if (sp > XB_SPIN_CAP) { atomicAdd(&bar[XB_TMO], 1u); break; } }
    }
    nloc = mine > 0u ? mine : 1u; nx = cnt > 0u ? cnt : 1u;
}

__device__ __forceinline__ void xcd_barrier(const XcdBarrier& b) {
    asm volatile("s_waitcnt vmcnt(0)" ::: "memory");
    __syncthreads();
    if (threadIdx.x == 0) {
        unsigned* bar = b.bar;
        __builtin_amdgcn_s_waitcnt(0);
        unsigned nloc = b.st[0], nx = b.st[1];
        if (nloc == 0u) { xcd_barrier_complete(bar, b.x, nloc, nx); b.st[0] = nloc; b.st[1] = nx; }
        const unsigned old = xb_add(&bar[XB_XSUB(b.x)], 1u);
        const unsigned gen = old / nloc;
        if (old + 1u == (gen + 1u) * nloc) {
            __builtin_amdgcn_fence(__ATOMIC_RELEASE, "agent");
            asm volatile("s_waitcnt vmcnt(0)" ::: "memory");
            const unsigned og = xb_add(&bar[XB_TOP], 1u);
            const unsigned tg = og / nx;
            if (og + 1u == (tg + 1u) * nx) xb_add(&bar[XB_TOPGEN], 1u);
            else XB_SPIN(xb_ld(&bar[XB_TOPGEN]) == tg, bar);
            __builtin_amdgcn_fence(__ATOMIC_ACQUIRE, "agent");
            xb_add(&bar[XB_XGEN(b.x)], 1u);
            asm volatile("s_waitcnt vmcnt(0)" ::: "memory");
        } else {
            XB_SPIN(xb_ld(&bar[XB_XGEN(b.x)]) == gen, bar);
            __builtin_amdgcn_fence(__ATOMIC_ACQUIRE, "agent");
            asm volatile("s_waitcnt vmcnt(0)" ::: "memory");
        }
    }
    __syncthreads();
}


#define REP_P0 1
#define REP_P1 1
#define REP_ATT 1
#define REP_SGU 1
#define REP_P3 1
#define REP_P4 1
#ifndef SKIP_P0
#define SKIP_P0 0
#endif
#ifndef SKIP_P1
#define SKIP_P1 0
#endif
#ifndef SKIP_P2
#define SKIP_P2 0
#endif
#ifndef SKIP_P3
#define SKIP_P3 0
#endif
#ifndef SKIP_P4
#define SKIP_P4 0
#endif
__global__ void __launch_bounds__(512, 2) hybrid_fwd(Params p) {
    extern __shared__ __attribute__((aligned(16))) unsigned char lds_raw[];
    LAS unsigned char* lds = (LAS unsigned char*)lds_raw;
    cg::grid_group grid = cg::this_grid();
    const int G = gridDim.x, lo = p.ph_lo, hi = p.ph_hi;
    const u16* Bt1 = (const u16*)(p.ws + WS_BT1); const u16* Bt3 = (const u16*)(p.ws + WS_BT3); const u16* Bt4 = (const u16*)(p.ws + WS_BT4);
    u16* PROJ = (u16*)(p.ws + WS_PROJ); u16* MRG = (u16*)(p.ws + WS_MRG); float* KMP = (float*)(p.ws + WS_KMP); u16* HAB = (u16*)p.out;
#define IN(k) (lo <= (k) && (k) < hi)
#define SEAM(k) do { if (IN(k) && IN((k) + 1)) xcd_barrier(bar); } while (0)
    if (threadIdx.x < 4) ((LAS unsigned*)(lds + LDS_MISC))[threadIdx.x] = 0u;
    __syncthreads();
    XcdBarrier bar; bar.bar = (unsigned*)(p.ws + WS_BAR); bar.x = 0; bar.st = nullptr;
    if (hi - lo > 1) bar = xcd_barrier_post((unsigned*)(p.ws + WS_BAR), (volatile LAS unsigned*)(lds + LDS_MISC));
    if (hi > 99) grid.sync();
    if (IN(0) && !SKIP_P0) {
#pragma unroll 1
        for (int rep = 0; rep < REP_P0; ++rep) { phase_prep(p, lds, G); __syncthreads(); } }
    SEAM(0);
    if (IN(1) && !SKIP_P1) {
        const float* HSC = (const float*)(p.ws + WS_HSC); const float* WSC = (const float*)(p.ws + WS_WSC);
        {
            pg8::Gemm g{(const u16*)(p.ws + WS_H8), (const u16*)(p.ws + WS_W8), TOK, NI8_TILES * 256, DM / 2}; pg8::StaticOrder S; S.init(TOK, NI8_TILES * 256, G, (int)blockIdx.x, REP_P1, 6);
            pg8::EpiProj<true> E{PROJ, p.q_g, p.k_g, p.sgu_g, KMP, (LAS float*)(lds + LDS_XCH), HSC, WSC};
            pg8::gemm_phase<pg8::EpiProj<true>, pg8::StaticOrder, true, true, true>(lds, g, S, E);
        }
        {
            pg8::Gemm g{HAB, Bt1, TOK, NBF_TILES * 256, DM}; pg8::StaticOrder S; S.init(TOK, NBF_TILES * 256, G, (int)blockIdx.x, REP_P1, 4);
            pg8::EpiProj<false> E{PROJ, p.q_g, p.k_g, p.sgu_g, KMP, (LAS float*)(lds + LDS_XCH), HSC, WSC};
            pg8::gemm_phase<pg8::EpiProj<false>, pg8::StaticOrder, true, true, false>(lds, g, S, E);
        }
    }
    SEAM(1);
    if (IN(2) && !SKIP_P2) {
#ifndef SKIP_SGU
        sgu_phase(p, lds, (int)blockIdx.x, G, NB * 32 * 8 * REP_SGU);
#endif
#ifndef SKIP_ATT
        for (int L0 = blockIdx.x; L0 < 256 * REP_ATT; L0 += G) { const int Lr = L0 & 255, L = ((Lr & 7) << 5) | (Lr >> 3);
            const int bh = L >> 3, xx = L & 7, b = bh >> 3, h = bh & 7;
            att::BlockRef r0, r1;
            const u16* Pb = PROJ + (size_t)b * SEQ * LDP + h * HD;
            r0.K = r1.K = Pb + C_K; r0.V = r1.V = Pb + C_V; r0.KM = r1.KM = KMP + ((size_t)(b * 16) * 8 + h) * 256;
            r0.qb = xx; r1.qb = 15 - xx;
            r0.Q = Pb + (size_t)r0.qb * 256 * LDP + C_Q; r0.Z = Pb + (size_t)r0.qb * 256 * LDP + C_ZA; r0.O = HAB + ((size_t)b * SEQ + r0.qb * 256) * DM + h * HD;
            r1.Q = Pb + (size_t)r1.qb * 256 * LDP + C_Q; r1.Z = Pb + (size_t)r1.qb * 256 * LDP + C_ZA; r1.O = HAB + ((size_t)b * SEQ + r1.qb * 256) * DM + h * HD;
            att::Seam S;
            att::moba_prime(r0, (char*)lds_raw, S);
            att::BlockRef cur = r0;
#pragma unroll 1
            for (int pass = 0; pass < 2; ++pass) { att::moba_block(cur, r1, (char*)lds_raw, S); cur = r1; }
            asm volatile("s_waitcnt vmcnt(0)" ::: "memory"); __syncthreads();
        }
#endif
    }
    SEAM(2);
    if (IN(3) && !SKIP_P3) {
        pg8::Gemm g{HAB, Bt3, TOK, DM, DM}; pg8::StaticOrder S; S.init(TOK, DM, G, (int)blockIdx.x, REP_P3, 4);
        pg8::EpiMerge E{PROJ, MRG};
        pg8::gemm_phase<pg8::EpiMerge, pg8::StaticOrder, true, true>(lds, g, S, E);
    }
    SEAM(3);
    if (IN(4) && !SKIP_P4) {
        pg8::Gemm g{MRG, Bt4, TOK, DM, DM}; pg8::StaticOrder S; S.init(TOK, DM, G, (int)blockIdx.x, REP_P4, 4);
        pg8::EpiOut E{p.x, p.out};
        pg8::gemm_phase<pg8::EpiOut, pg8::StaticOrder, true, true>(lds, g, S, E);
    }
#undef IN
#undef SEAM
}

#ifndef N_LAUNCHES
#define N_LAUNCHES 1
#endif
extern "C" void kernel_launch(void* const* d_in, const int* in_sizes, int n_in, void* d_out, int out_size, void* d_ws, size_t ws_size, hipStream_t stream) {
    static int grid = 0;
    if (grid == 0) {
        if (n_in != 11 || in_sizes[0] != TOK * DM || out_size != TOK * DM || ws_size < WS_END) { fprintf(stderr, "kernel_launch: unexpected shapes (n_in %d in0 %d out %d ws %zu need %zu)\n", n_in, n_in > 0 ? in_sizes[0] : -1, out_size, ws_size, (size_t)WS_END); grid = -1; return; }
        int dev = 0, cus = 0, per_cu = 0;
        (void)hipGetDevice(&dev); (void)hipDeviceGetAttribute(&cus, hipDeviceAttributeMultiprocessorCount, dev);
        if (hipFuncSetAttribute((const void*)hybrid_fwd, hipFuncAttributeMaxDynamicSharedMemorySize, LDS_TOTAL) != hipSuccess) { fprintf(stderr, "kernel_launch: hipFuncSetAttribute failed\n"); grid = -1; return; }
        if (hipOccupancyMaxActiveBlocksPerMultiprocessor(&per_cu, (const void*)hybrid_fwd, 512, LDS_TOTAL) != hipSuccess || per_cu < 1) { fprintf(stderr, "kernel_launch: occupancy query says %d blocks/CU\n", per_cu); grid = -1; return; }
        if (per_cu > 1) per_cu = 1;
        grid = cus * per_cu;
    }
    if (grid < 0) return;
    Params p{};
    p.x = (const float*)d_in[0]; p.norm_g = (const float*)d_in[1]; p.w_in = (const float*)d_in[2]; p.q_g = (const float*)d_in[3]; p.k_g = (const float*)d_in[4];
    p.sgu_g = (const float*)d_in[5]; p.w_s = (const float*)d_in[6]; p.b_s = (const float*)d_in[7]; p.w_a = (const float*)d_in[8]; p.w_b = (const float*)d_in[9]; p.w_out = (const float*)d_in[10];
    p.out = (float*)d_out; p.ws = (unsigned char*)d_ws;
#if N_LAUNCHES == 1
    if (hipMemsetAsync((char*)d_ws + WS_BAR, 0, 16384, stream) != hipSuccess) { fprintf(stderr, "kernel_launch: barrier memset failed\n"); return; }
    p.ph_lo = 0; p.ph_hi = 5;
    void* args[] = {&p};
    hipError_t e = hipLaunchCooperativeKernel((const void*)hybrid_fwd, dim3(grid), dim3(512), args, LDS_TOTAL, stream);
    if (e != hipSuccess) fprintf(stderr, "cooperative launch failed: %s (grid %d)\n", hipGetErrorString(e), grid);
#else
    for (int ph = 0; ph < 5; ++ph) { p.ph_lo = ph; p.ph_hi = ph + 1; hipLaunchKernelGGL(hybrid_fwd, dim3(grid), dim3(512), LDS_TOTAL, stream, p); }
#endif
}
```

```cpp
#include <hip/hip_runtime.h>
#include <hip/hip_cooperative_groups.h>
#include <hip/hip_bf16.h>
#include <cstdio>
#include <cstdint>
namespace cg = cooperative_groups;

constexpr int DM = 2048, NB = 4, SEQ = 4096, TOK = NB * SEQ, NH = 8, HD = 128, LDP = 11264;
constexpr int C_Q = 0, C_K = 1024, C_V = 2048, C_ZA = 3072, C_UB = 4096, C_VB = 5120, C_ZB = 6144, C_GA = 7168, C_GB = 9216;
constexpr float EPS = 1e-6f;
constexpr size_t WS_BT1 = 0;
constexpr size_t WS_BT3 = WS_BT1 + (size_t)LDP * DM * 2;
constexpr size_t WS_BT4 = WS_BT3 + (size_t)DM * DM * 2;
constexpr size_t WS_PROJ = WS_BT4 + (size_t)DM * DM * 2;
constexpr size_t WS_MRG = WS_PROJ + (size_t)TOK * LDP * 2;
constexpr size_t WS_KMP = WS_MRG + (size_t)TOK * DM * 2;
constexpr size_t WS_H8 = WS_KMP + (size_t)64 * 8 * 2 * 128 * 4;
constexpr size_t WS_HSC = WS_H8 + (size_t)TOK * DM;
constexpr size_t WS_WSC = WS_HSC + (size_t)TOK * 4;
constexpr size_t WS_BAR = WS_WSC + (size_t)9216 * 4;
constexpr size_t WS_END = WS_BAR + 16384;
constexpr int NI8_TILES = 36, NBF_TILES = 8;
constexpr size_t WS_W8 = WS_BT1 + (size_t)NBF_TILES * 256 * DM * 2;
constexpr int LDS_XCH = 131072;
constexpr int LDS_MISC = LDS_XCH + 10240;
constexpr int LDS_TOTAL = LDS_MISC + 16;

namespace pg8 {
#define PG8_LAS __attribute__((address_space(3)))
typedef unsigned short bf16_t;
typedef short bf16x8 __attribute__((ext_vector_type(8)));
typedef float f32x4 __attribute__((ext_vector_type(4)));
typedef unsigned u32x4 __attribute__((ext_vector_type(4)));
typedef int i32x4 __attribute__((ext_vector_type(4)));
typedef float f32x2 __attribute__((ext_vector_type(2)));
constexpr int BM = 256, BK = 64, HALF = 128, HTB = HALF * BK * 2  , STAGE_BYTES = 8 * HTB, NXCD = 8, WGM = 8;

__host__ __device__ __forceinline__ int lds_byte(int r, int c) { const int st = (r >> 4) * 2 + (c >> 5), rr = r & 15, cc = c & 31, ob = rr * 64 + cc * 2; return st * 1024 + (ob ^ (((ob >> 9) & 1) << 5)); }
__host__ __device__ __forceinline__ void stage_rc(int b, int& R, int& C) { const int st = b / 1024, sb = b % 1024, swz = sb ^ (((sb >> 9) & 1) << 5); R = (st >> 1) * 16 + swz / 64; C = (st & 1) * 32 + (swz % 64) / 2; }
__host__ __device__ __forceinline__ int perm32(int rho) { const int n = rho >> 4, i = rho & 15; return 8 * (i >> 2) + 4 * n + (i & 3); }

struct Unit { int pm, pn; };
struct Gemm { const bf16_t* A; const bf16_t* Bt; int M, N, K; };

struct StaticOrder {
    int nM, nN, nwg, G, c, rep, wgm;
    __host__ __device__ void init(int M, int N, int G_, int c_, int rep_ = 1, int wgm_ = WGM) { nM = M / BM; nN = N / BM; nwg = nM * nN; G = G_; c = c_; rep = rep_; wgm = wgm_; }
    __host__ __device__ bool next(int i, Unit& u) const {
        long L = (long)i * G + c; if (L >= (long)nwg * rep) return false; L %= nwg;
        int wgid = (int)L; { const int q = nwg / NXCD, r = nwg % NXCD, xcd = wgid % NXCD, off = wgid / NXCD; wgid = (xcd < r ? xcd * (q + 1) : r * (q + 1) + (xcd - r) * q) + off; }
        const int nig = wgm * nN, gid = wgid / nig, fm = gid * wgm, gsz = (nM - fm) < wgm ? (nM - fm) : wgm;
        u.pm = fm + ((wgid % nig) % gsz); u.pn = (wgid % nig) / gsz; return true;
    }
    __device__ __forceinline__ void a_ready(const Unit&) const {}
    __device__ __forceinline__ void done(const Unit&) const {}
};

__device__ __forceinline__ unsigned cvt_pk_bf16(float lo, float hi) { unsigned r; asm volatile("v_cvt_pk_bf16_f32 %0, %1, %2" : "=v"(r) : "v"(lo), "v"(hi)); return r; }
__device__ __forceinline__ float bf_lo(unsigned w) { return __uint_as_float(w << 16); }
__device__ __forceinline__ float bf_hi(unsigned w) { return __uint_as_float(w & 0xffff0000u); }
__device__ __forceinline__ float sigmoid_f(float x) { return __builtin_amdgcn_rcpf(1.0f + __builtin_amdgcn_exp2f(-1.4426950408889634f * x)); }
__device__ __forceinline__ float silu_f(float x) { return x * sigmoid_f(x); }
__device__ __forceinline__ float gelu_f(float x) { const float u = 0.7978845608028654f * (x + 0.044715f * x * x * x); return x * sigmoid_f(2.0f * u); }

template <bool I8E> struct EpiProj {
    static constexpr bool PERM = true, AFTER_DRAIN = false, MIDHOOK = false;
    bf16_t* P; const float* qg; const float* kg; const float* sg; float* kmp; PG8_LAS float* xch;
    const float* hs; const float* wsc;
    __device__ __forceinline__ void mid(f32x4 (&)[2][2][4][2], const Unit&, int, int, int, int) const {}
    __device__ __forceinline__ void operator()(f32x4 (&acc)[2][2][4][2], const Unit& u, int wr, int wc, int fr, int fq) const {
        const int pn = I8E ? (u.pn < 16 ? u.pn : (u.pn < 20 ? u.pn + 4 : 28)) : (u.pn < 4 ? u.pn + 16 : u.pn + 20), colw = wc * 32 + 8 * fq;
        int lid = fr | (fq << 4); if constexpr (I8E) asm volatile("" : "+v"(lid));
        const int colw2 = wc * 32 + 8 * (lid >> 4), fr2 = lid & 15;
        if constexpr (I8E) {
            const float* hp = hs + u.pm * BM + wr * 64 + fr2; const float* wp = wsc + u.pn * BM + colw2;
#pragma unroll
            for (int bj = 0; bj < 2; ++bj) { const f32x4 c0 = *(const f32x4*)(wp + bj * HALF), c1 = *(const f32x4*)(wp + bj * HALF + 4);
#pragma unroll
                for (int ai = 0; ai < 2; ++ai)
#pragma unroll
                    for (int m = 0; m < 4; ++m) { const float rs = hp[ai * HALF + m * 16];
                        acc[ai][bj][m][0] = acc[ai][bj][m][0] * (c0 * rs); acc[ai][bj][m][1] = acc[ai][bj][m][1] * (c1 * rs); }
                asm volatile("" ::: "memory"); }
        }
        int act = 0; const float* gain = nullptr; bool km = false;
        if (pn < 4) { gain = qg; } else if (pn < 8) { gain = kg; km = true; } else if (pn < 12) { } else if (pn < 16) { act = 1; }
        else if (pn < 20) { act = 2; } else if (pn < 24) { act = 2; gain = sg; } else if (pn < 28) { act = 1; } else { act = 3; }
        const bool gate = I8E && u.pn >= 20;
        const int colbase = gate ? C_GA + 128 * (u.pn - 20) : pn * BM, bjoff = gate ? (C_GB - C_GA) : HALF;
        bf16_t* ubase = P + (size_t)(u.pm * BM) * LDP + colbase;
        const unsigned loff = (unsigned)((wr * 64 + fr2) * LDP + colw2) * 2u;
#define EPI_STORE_GROUP(ai, m) do { char* rowp_ = (char*)(ubase + ((ai) * HALF + (m) * 16) * LDP) + loff; _Pragma("unroll") for (int bj_ = 0; bj_ < 2; ++bj_) { \
            const f32x4 v0_ = acc[ai][bj_][m][0], v1_ = acc[ai][bj_][m][1]; u32x4 w_; w_.x = cvt_pk_bf16(v0_[0], v0_[1]); w_.y = cvt_pk_bf16(v0_[2], v0_[3]); w_.z = cvt_pk_bf16(v1_[0], v1_[1]); w_.w = cvt_pk_bf16(v1_[2], v1_[3]); \
            *(u32x4*)(rowp_ + bj_ * bjoff * 2) = w_; } } while (0)
        if (act != 0) {
            const float L2E = -1.4426950408889634f;
            const float c1 = ((act == 2) ? 1.5957691216057308f : 1.0f) * L2E, c3 = ((act == 2) ? 0.07135481627260025f : 0.0f) * L2E, ma = (act == 3) ? 0.0f : 1.0f, mb = (act == 3) ? 1.0f : 0.0f;
            const f32x2 C1 = {c1, c1}, C3 = {c3, c3}, MA = {ma, ma}, MB = {mb, mb}, ONE = {1.0f, 1.0f};
#pragma unroll
            for (int ai = 0; ai < 2; ++ai)
#pragma unroll
                for (int m = 0; m < 4; ++m) { f32x4 dB[2];
#pragma unroll
                    for (int bj = 0; bj < 2; ++bj)
#pragma unroll
                        for (int n = 0; n < 2; ++n) {
#pragma unroll
                            for (int j = 0; j < 4; j += 2) { const f32x2 x = {acc[ai][bj][m][n][j], acc[ai][bj][m][n][j + 1]};
                                const f32x2 t = x * ((x * x) * C3 + C1); f32x2 e; e.x = __builtin_amdgcn_exp2f(t.x); e.y = __builtin_amdgcn_exp2f(t.y);
                                const f32x2 d = e + ONE; f32x2 r; r.x = __builtin_amdgcn_rcpf(d.x); r.y = __builtin_amdgcn_rcpf(d.y);
                                if (bj == 1) { dB[n][j] = d.x; dB[n][j + 1] = d.y; }
                                const f32x2 o = (x * MA + MB) * r; acc[ai][bj][m][n][j] = o.x; acc[ai][bj][m][n][j + 1] = o.y; }
                            __builtin_amdgcn_sched_barrier(0); }
                    if constexpr (I8E) if (gate) {
#pragma unroll
                        for (int n = 0; n < 2; ++n)
#pragma unroll
                            for (int j = 0; j < 4; ++j) acc[ai][0][m][n][j] = acc[ai][0][m][n][j] * fminf(dB[n][j], 1e30f); }
                    if (!gain) { EPI_STORE_GROUP(ai, m); __builtin_amdgcn_sched_barrier(0); }
                }
        }
        unsigned xbo = (unsigned)(((wr * 64 + fr) * 2) * 4 + wc) * 4u; asm volatile("" : "+v"(xbo));
        PG8_LAS float* xb = (PG8_LAS float*)((PG8_LAS char*)xch + xbo);
        if (gain) {
#pragma unroll
            for (int ai = 0; ai < 2; ++ai)
#pragma unroll
                for (int m = 0; m < 4; ++m)
#pragma unroll
                    for (int bj = 0; bj < 2; ++bj) {
                        const f32x4 a = acc[ai][bj][m][0], b = acc[ai][bj][m][1];
                        float s = (a[0] * a[0] + a[1] * a[1]) + (a[2] * a[2] + a[3] * a[3]) + (b[0] * b[0] + b[1] * b[1]) + (b[2] * b[2] + b[3] * b[3]);
                        s += __shfl_xor(s, 16); s += __shfl_xor(s, 32);
                        if (fq == 0) xb[((ai * HALF + m * 16) * 2 + bj) * 4] = s;
                    }
            asm volatile("s_waitcnt lgkmcnt(0)" ::: "memory"); __builtin_amdgcn_s_barrier(); asm volatile("" ::: "memory");
            {
                const int t = threadIdx.x; const f32x4 pp = *(const PG8_LAS f32x4*)(xch + t * 4);
                xch[2048 + t] = __builtin_amdgcn_rsqf(((pp[0] + pp[1]) + (pp[2] + pp[3])) * (1.0f / 128.0f) + EPS); }
            asm volatile("s_waitcnt lgkmcnt(0)" ::: "memory"); __builtin_amdgcn_s_barrier(); asm volatile("" ::: "memory");
            const f32x4 g0 = *(const f32x4*)(gain + colw2), g1 = *(const f32x4*)(gain + colw2 + 4);
#pragma unroll
            for (int ai = 0; ai < 2; ++ai)
#pragma unroll
                for (int m = 0; m < 4; ++m) {
                    const f32x2 rs = *(const PG8_LAS f32x2*)(xch + 2048 + (ai * HALF + wr * 64 + m * 16 + fr) * 2);
                    acc[ai][0][m][0] = acc[ai][0][m][0] * rs[0] * g0; acc[ai][0][m][1] = acc[ai][0][m][1] * rs[0] * g1;
                    acc[ai][1][m][0] = acc[ai][1][m][0] * rs[1] * g0; acc[ai][1][m][1] = acc[ai][1][m][1] * rs[1] * g1;
                }
            if (km) {
#pragma unroll
                for (int bj = 0; bj < 2; ++bj)
#pragma unroll
                    for (int n = 0; n < 2; ++n) {
                        f32x4 cs = (f32x4){0.f, 0.f, 0.f, 0.f};
#pragma unroll
                        for (int ai = 0; ai < 2; ++ai)
#pragma unroll
                            for (int m = 0; m < 4; ++m) cs += acc[ai][bj][m][n];
#pragma unroll
                        for (int j = 0; j < 4; ++j) { float v = cs[j]; v += __shfl_xor(v, 1); v += __shfl_xor(v, 2); v += __shfl_xor(v, 4); v += __shfl_xor(v, 8); cs[j] = v; }
                        if (fr2 == 0) *(f32x4*)(kmp + ((size_t)(u.pm * 8 + (pn - 4) * 2 + bj) * 2 + wr) * 128 + colw2 + 4 * n) = cs;
                    }
            }
        }
        if (gain || act == 0) {
#pragma unroll
            for (int ai = 0; ai < 2; ++ai)
#pragma unroll
                for (int m = 0; m < 4; ++m) EPI_STORE_GROUP(ai, m);
        }
#undef EPI_STORE_GROUP
    }
};
struct EpiMerge {
    static constexpr bool PERM = true, AFTER_DRAIN = false, MIDHOOK = true;
    const bf16_t* P; bf16_t* O;
    __device__ __forceinline__ void mid(f32x4 (&acc)[2][2][4][2], const Unit& u, int wr, int wc, int fr, int fq) const {
        const bf16_t* ubase = P + (size_t)(u.pm * BM) * LDP + u.pn * BM + C_GA;
        unsigned loff = (unsigned)((wr * 64 + fr) * LDP + wc * 32 + 8 * fq) * 2u; asm volatile("" : "+v"(loff));
#pragma unroll
        for (int ai = 0; ai < 2; ++ai) {
            u32x4 a[4][2];
#pragma unroll
            for (int m = 0; m < 4; ++m)
#pragma unroll
                for (int bj = 0; bj < 2; ++bj) a[m][bj] = *(const u32x4*)((const char*)(ubase + (ai * HALF + m * 16) * LDP) + loff + bj * HALF * 2);
#pragma unroll
            for (int m = 0; m < 4; ++m)
#pragma unroll
                for (int bj = 0; bj < 2; ++bj) { const u32x4 w = a[m][bj]; f32x4 r0, r1;
                    r0[0] = bf_lo(w.x); r0[1] = bf_hi(w.x); r0[2] = bf_lo(w.y); r0[3] = bf_hi(w.y); r1[0] = bf_lo(w.z); r1[1] = bf_hi(w.z); r1[2] = bf_lo(w.w); r1[3] = bf_hi(w.w);
                    acc[ai][bj][m][0] *= r0; acc[ai][bj][m][1] *= r1; }
            asm volatile("" ::: "memory"); }
    }
    __device__ __forceinline__ void operator()(f32x4 (&acc)[2][2][4][2], const Unit& u, int wr, int wc, int fr, int fq) const {
        const bf16_t* ubase = P + (size_t)(u.pm * BM) * LDP + u.pn * BM + C_GB;
        bf16_t* obase = O + (size_t)(u.pm * BM) * DM + u.pn * BM;
        const unsigned loff = (unsigned)((wr * 64 + fr) * LDP + wc * 32 + 8 * fq) * 2u, ooff = (unsigned)((wr * 64 + fr) * DM + wc * 32 + 8 * fq) * 2u;
#pragma unroll
        for (int ai = 0; ai < 2; ++ai) {
            u32x4 bq[4][2];
#pragma unroll
            for (int m = 0; m < 4; ++m)
#pragma unroll
                for (int bj = 0; bj < 2; ++bj) bq[m][bj] = *(const u32x4*)((const char*)(ubase + (ai * HALF + m * 16) * LDP) + loff + bj * HALF * 2);
#pragma unroll
            for (int m = 0; m < 4; ++m) { char* orow = (char*)(obase + (ai * HALF + m * 16) * DM) + ooff;
#pragma unroll
                for (int bj = 0; bj < 2; ++bj) { const u32x4 b = bq[m][bj];
                    const f32x4 v0 = acc[ai][bj][m][0], v1 = acc[ai][bj][m][1];
                    u32x4 w; w.x = cvt_pk_bf16(v0[0] * fmaxf(bf_lo(b.x), 1e-30f), v0[1] * fmaxf(bf_hi(b.x), 1e-30f)); w.y = cvt_pk_bf16(v0[2] * fmaxf(bf_lo(b.y), 1e-30f), v0[3] * fmaxf(bf_hi(b.y), 1e-30f));
                    w.z = cvt_pk_bf16(v1[0] * fmaxf(bf_lo(b.z), 1e-30f), v1[1] * fmaxf(bf_hi(b.z), 1e-30f)); w.w = cvt_pk_bf16(v1[2] * fmaxf(bf_lo(b.w), 1e-30f), v1[3] * fmaxf(bf_hi(b.w), 1e-30f));
                    *(u32x4*)(orow + bj * HALF * 2) = w; } }
            asm volatile("" ::: "memory"); }
    }
};
struct EpiOut {
    static constexpr bool PERM = false, AFTER_DRAIN = false, MIDHOOK = false;
    const float* __restrict__ X; float* __restrict__ O;
    __device__ __forceinline__ void mid(f32x4 (&)[2][2][4][2], const Unit&, int, int, int, int) const {}
    __device__ __forceinline__ void operator()(f32x4 (&acc)[2][2][4][2], const Unit& u, int wr, int wc, int fr, int fq) const {
        const size_t r0i = (size_t)(u.pm * BM + wr * 64 + fr); const int col = u.pn * BM + wc * 32 + 4 * fq;
        f32x4 xq[4][2][2][2];
#define EO_LOAD(q) do { _Pragma("unroll") for (int mm = 0; mm < 2; ++mm) _Pragma("unroll") for (int bj = 0; bj < 2; ++bj) _Pragma("unroll") for (int n = 0; n < 2; ++n) \
            xq[q][mm][bj][n] = *(const f32x4*)(X + (r0i + ((q) >> 1) * HALF + (2 * ((q) & 1) + mm) * 16) * DM + col + bj * HALF + 16 * n); } while (0)
#define EO_STORE(q) do { _Pragma("unroll") for (int mm = 0; mm < 2; ++mm) _Pragma("unroll") for (int bj = 0; bj < 2; ++bj) _Pragma("unroll") for (int n = 0; n < 2; ++n) \
            *(f32x4*)(O + (r0i + ((q) >> 1) * HALF + (2 * ((q) & 1) + mm) * 16) * DM + col + bj * HALF + 16 * n) = xq[q][mm][bj][n] + acc[(q) >> 1][bj][2 * ((q) & 1) + mm][n]; } while (0)
        EO_LOAD(0); EO_LOAD(1); asm volatile("" ::: "memory");
        EO_LOAD(2); asm volatile("" ::: "memory"); EO_STORE(0); asm volatile("" ::: "memory");
        EO_LOAD(3); asm volatile("" ::: "memory"); EO_STORE(1); asm volatile("" ::: "memory");
        EO_STORE(2); asm volatile("" ::: "memory"); EO_STORE(3);
#undef EO_LOAD
#undef EO_STORE
    }
};

template <class Epi, class Sched, bool ALIGN_EPI = false, bool SP2 = false, bool I8 = false>
__device__ __forceinline__ void gemm_phase(PG8_LAS unsigned char* lds, const Gemm g, const Sched& S, const Epi& E) {
    int tid_ = threadIdx.x; asm volatile("" : "+v"(tid_));
    const int tid = tid_, wid = __builtin_amdgcn_readfirstlane(tid >> 6), lane = tid & 63, wr = wid >> 2, wc = wid & 3, fr = lane & 15, fq = lane >> 4;
    const int K = g.K, nt = K / BK;
    unsigned voffA[2], voffB[2];
#pragma unroll
    for (int i = 0; i < 2; ++i) { int R, C; stage_rc(tid * 16 + i * 8192, R, C); const int Rb = Epi::PERM ? ((R & ~31) + perm32(R & 31)) : R;
        voffA[i] = (unsigned)(R * K + C) * 2u; voffB[i] = (unsigned)(Rb * K + C) * 2u; }
    const size_t kstep = (size_t)(BK * 2);
    const size_t hstep = (size_t)HALF * K * 2;
    const size_t tstep = 2 * hstep;
    const unsigned ldsw = (unsigned)wid * 1024u;
    const int aoff = lds_byte(wr * 64 + fr, fq * 8), boff = lds_byte(wc * 32 + fr, fq * 8);
#define PG8_SA(b, h) (((b) * 2 + (h)) * HTB)
#define PG8_SB(b, h) ((4 + (b) * 2 + (h)) * HTB)
#define PG8_STAGE(bufoff, gbase, voff) do { _Pragma("unroll") for (int _i = 0; _i < 2; ++_i) \
        __builtin_amdgcn_global_load_lds((const unsigned*)((const char*)(gbase) + (voff)[_i]), (PG8_LAS unsigned*)(lds + (bufoff) + ldsw + _i * 8192), 16, 0, 0); } while (0)
#define PG8_LDA(dst, b, h) do { _Pragma("unroll") for (int m = 0; m < 4; ++m) _Pragma("unroll") for (int k = 0; k < 2; ++k) dst[m][k] = *(const PG8_LAS bf16x8*)(lds + PG8_SA(b, h) + aoff + m * 2048 + k * 1024); } while (0)
#define PG8_LDB(dst, b, h) do { _Pragma("unroll") for (int n = 0; n < 2; ++n) _Pragma("unroll") for (int k = 0; k < 2; ++k) dst[n][k] = *(const PG8_LAS bf16x8*)(lds + PG8_SB(b, h) + boff + n * 2048 + k * 1024); } while (0)
#define PG8_MMA(ai, bj, At, Bt) do { __builtin_amdgcn_s_setprio(1); _Pragma("unroll") for (int m = 0; m < 4; ++m) _Pragma("unroll") for (int n = 0; n < 2; ++n) _Pragma("unroll") for (int k = 0; k < 2; ++k) \
        { if constexpr (I8) acc[ai][bj][m][n] = __builtin_bit_cast(f32x4, __builtin_amdgcn_mfma_i32_16x16x64_i8(__builtin_bit_cast(i32x4, Bt[n][k]), __builtin_bit_cast(i32x4, At[m][k]), __builtin_bit_cast(i32x4, acc[ai][bj][m][n]), 0, 0, 0)); \
          else acc[ai][bj][m][n] = __builtin_amdgcn_mfma_f32_16x16x32_bf16(Bt[n][k], At[m][k], acc[ai][bj][m][n], 0, 0, 0); } __builtin_amdgcn_s_setprio(0); } while (0)
#define PG8_WAIT_V(n) asm volatile("s_waitcnt vmcnt(" #n ")" ::: "memory")
#define PG8_WAIT_L(n) asm volatile("s_waitcnt lgkmcnt(" #n ")" ::: "memory")
#define PG8_BAR __builtin_amdgcn_s_barrier()
#define PG8_SCHED __builtin_amdgcn_sched_barrier(0)
    Unit cur, nxt; int ui = 0;
    if (!S.next(0, cur)) return;
    f32x4 acc[2][2][4][2];
#pragma unroll
    for (int a = 0; a < 2; ++a)
#pragma unroll
        for (int b = 0; b < 2; ++b)
#pragma unroll
            for (int m = 0; m < 4; ++m)
#pragma unroll
                for (int n = 0; n < 2; ++n) acc[a][b][m][n] = (f32x4){0.f, 0.f, 0.f, 0.f};
    bf16x8 At[4][2], B0[2][2], B1[2][2];
    const char* cA = (const char*)g.A + (size_t)cur.pm * tstep; const char* cB = (const char*)g.Bt + (size_t)cur.pn * tstep;
    S.a_ready(cur);
    if constexpr (SP2) {
        PG8_STAGE(PG8_SB(0, 0), cB, voffB); PG8_STAGE(PG8_SB(0, 1), cB + hstep, voffB); PG8_STAGE(PG8_SA(0, 0), cA, voffA); PG8_STAGE(PG8_SA(0, 1), cA + hstep, voffA);
        if (wr == 1) PG8_BAR;
        PG8_WAIT_V(2); PG8_BAR;
        PG8_STAGE(PG8_SB(1, 0), cB + kstep, voffB); PG8_STAGE(PG8_SA(1, 0), cA + kstep, voffA); PG8_STAGE(PG8_SB(1, 1), cB + hstep + kstep, voffB);
        PG8_WAIT_V(6); PG8_BAR;
    } else {
        PG8_STAGE(PG8_SB(0, 0), cB, voffB); PG8_STAGE(PG8_SA(0, 0), cA, voffA); PG8_STAGE(PG8_SB(0, 1), cB + hstep, voffB); PG8_STAGE(PG8_SA(0, 1), cA + hstep, voffA);
        if (wr == 1) PG8_BAR;
        PG8_WAIT_V(4); PG8_BAR;
        PG8_STAGE(PG8_SB(1, 0), cB + kstep, voffB); PG8_STAGE(PG8_SA(1, 0), cA + kstep, voffA); PG8_STAGE(PG8_SB(1, 1), cB + hstep + kstep, voffB);
        PG8_WAIT_V(6); PG8_BAR;
    }
    for (;;) {
        const bool has_next = S.next(ui + 1, nxt);
        const char* nA = has_next ? (const char*)g.A + (size_t)nxt.pm * tstep : cA; const char* nB = has_next ? (const char*)g.Bt + (size_t)nxt.pn * tstep : cB;
        for (int t = 0; t < nt; t += 2) {
            if constexpr (Epi::MIDHOOK) { if (t == (nt >> 1)) E.mid(acc, cur, wr, wc, fr, fq); }
            const bool last = (t == nt - 2);
            const char* a1 = cA + (size_t)(t + 1) * kstep;
            const char* a2 = last ? nA : cA + (size_t)(t + 2) * kstep; const char* b2 = last ? nB : cB + (size_t)(t + 2) * kstep;
            const char* a3 = a2 + kstep; const char* b3 = b2 + kstep;
            if (last && has_next) S.a_ready(nxt);
            if constexpr (SP2) {
            PG8_LDB(B0, 0, 0); PG8_LDB(B1, 0, 1); PG8_SCHED; PG8_LDA(At, 0, 0); PG8_STAGE(PG8_SA(1, 1), a1 + hstep, voffA);
            PG8_WAIT_V(8); PG8_WAIT_L(0); PG8_BAR; PG8_MMA(0, 0, At, B0); PG8_MMA(0, 1, At, B1); PG8_BAR; PG8_SCHED;
            PG8_LDA(At, 0, 1); PG8_STAGE(PG8_SB(0, 0), b2, voffB); PG8_STAGE(PG8_SB(0, 1), b2 + hstep, voffB); PG8_STAGE(PG8_SA(0, 0), a2, voffA);
            PG8_WAIT_V(8); PG8_WAIT_L(0); PG8_BAR; PG8_MMA(1, 0, At, B0); PG8_MMA(1, 1, At, B1); PG8_BAR; PG8_SCHED;
            PG8_LDB(B0, 1, 0); PG8_LDB(B1, 1, 1); PG8_SCHED; PG8_LDA(At, 1, 0); PG8_STAGE(PG8_SA(0, 1), a2 + hstep, voffA);
            PG8_WAIT_V(8); PG8_WAIT_L(0); PG8_BAR; PG8_MMA(0, 0, At, B0); PG8_MMA(0, 1, At, B1); PG8_BAR; PG8_SCHED;
            PG8_LDA(At, 1, 1); PG8_STAGE(PG8_SB(1, 0), b3, voffB); PG8_STAGE(PG8_SB(1, 1), b3 + hstep, voffB); PG8_STAGE(PG8_SA(1, 0), a3, voffA);
            PG8_WAIT_V(8); PG8_WAIT_L(0); PG8_BAR; PG8_MMA(1, 0, At, B0); PG8_MMA(1, 1, At, B1); PG8_BAR; PG8_SCHED;
            } else {
            PG8_LDB(B0, 0, 0); PG8_SCHED; PG8_LDA(At, 0, 0); PG8_STAGE(PG8_SA(1, 1), a1 + hstep, voffA);
            PG8_WAIT_L(8); PG8_BAR; PG8_WAIT_L(0); PG8_MMA(0, 0, At, B0); PG8_BAR; PG8_SCHED;
            PG8_LDB(B1, 0, 1); PG8_STAGE(PG8_SB(0, 0), b2, voffB);
            PG8_BAR; PG8_WAIT_L(0); PG8_MMA(0, 1, At, B1); PG8_BAR;
            PG8_LDA(At, 0, 1); PG8_STAGE(PG8_SA(0, 0), a2, voffA);
            PG8_BAR; PG8_WAIT_L(0); PG8_MMA(1, 0, At, B0); PG8_BAR; PG8_SCHED;
            PG8_STAGE(PG8_SB(0, 1), b2 + hstep, voffB);
            PG8_WAIT_V(6); PG8_BAR; PG8_MMA(1, 1, At, B1); PG8_BAR;
            PG8_LDB(B0, 1, 0); PG8_SCHED; PG8_LDA(At, 1, 0); PG8_STAGE(PG8_SA(0, 1), a2 + hstep, voffA);
            PG8_WAIT_L(8); PG8_BAR; PG8_WAIT_L(0); PG8_MMA(0, 0, At, B0); PG8_BAR; PG8_SCHED;
            PG8_LDB(B1, 1, 1); PG8_STAGE(PG8_SB(1, 0), b3, voffB);
            PG8_BAR; PG8_WAIT_L(0); PG8_MMA(0, 1, At, B1); PG8_BAR;
            PG8_LDA(At, 1, 1); PG8_STAGE(PG8_SA(1, 0), a3, voffA);
            PG8_BAR; PG8_WAIT_L(0); PG8_MMA(1, 0, At, B0); PG8_BAR; PG8_SCHED;
            PG8_STAGE(PG8_SB(1, 1), b3 + hstep, voffB);
            PG8_WAIT_V(6); PG8_BAR; PG8_MMA(1, 1, At, B1); PG8_BAR;
            }
        }
        if constexpr (ALIGN_EPI) { if (wr == 0) PG8_BAR; }
        if constexpr (I8) {
#pragma unroll
            for (int a = 0; a < 2; ++a)
#pragma unroll
                for (int b = 0; b < 2; ++b)
#pragma unroll
                    for (int m = 0; m < 4; ++m)
#pragma unroll
                        for (int n = 0; n < 2; ++n)
#pragma unroll
                            for (int j = 0; j < 4; ++j) acc[a][b][m][n][j] = (float)__float_as_int(acc[a][b][m][n][j]);
        }
        if constexpr (!Epi::AFTER_DRAIN) { E(acc, cur, wr, wc, fr, fq); S.done(cur); }
        if (!has_next) break;
#pragma unroll
        for (int a = 0; a < 2; ++a)
#pragma unroll
            for (int b = 0; b < 2; ++b)
#pragma unroll
                for (int m = 0; m < 4; ++m)
#pragma unroll
                    for (int n = 0; n < 2; ++n) acc[a][b][m][n] = (f32x4){0.f, 0.f, 0.f, 0.f};
        cur = nxt; cA = nA; cB = nB; ++ui;
        if constexpr (ALIGN_EPI) { if (wr == 1) PG8_BAR; }
    }
    PG8_WAIT_V(0);
    if constexpr (!ALIGN_EPI) { if (wr == 0) PG8_BAR; }
    PG8_BAR;
    if constexpr (Epi::AFTER_DRAIN) { E.fused(acc, cur, wr, wc, fr, fq, lds, wid, lane); S.done(cur); }
#undef PG8_SA
#undef PG8_SB
#undef PG8_STAGE
#undef PG8_LDA
#undef PG8_LDB
#undef PG8_MMA
#undef PG8_WAIT_V
#undef PG8_WAIT_L
#undef PG8_BAR
#undef PG8_SCHED
}
}
namespace att {
typedef unsigned short u16;
typedef short bf16x8 __attribute__((ext_vector_type(8)));
typedef short s16x4 __attribute__((ext_vector_type(4)));
typedef float f32x16 __attribute__((ext_vector_type(16)));
typedef float f32x4 __attribute__((ext_vector_type(4)));
typedef unsigned u32x4 __attribute__((ext_vector_type(4)));
constexpr int D = 128, NW = 8, QBLK = 32, KVBLK = 64, QB = NW * QBLK;
constexpr int SHM_V = KVBLK * D * 2, SHM_K = KVBLK * D * 2;
constexpr int OFF_WS = 2 * SHM_V + 2 * SHM_K, OFF_KM = OFF_WS + NW * 64 * 4, ATT_LDS = OFF_KM + 8192;
constexpr float SCALE = 0.08838834764831845f, THR = 8.f;
#define KSWZ(row, colB) ((row) * 256 + ((colB) ^ (((row) & 7) << 4)))
#define SBAR() __builtin_amdgcn_sched_barrier(0)
__device__ __forceinline__ int v_st(int k, int c) { const int kk = (k & ~0xC) | ((k & 4) << 1) | ((k & 8) >> 1); return ((kk >> 3) * 4 + (c >> 5)) * 512 + ((kk & 7) * 32 + (c & 31)) * 2; }
__device__ __forceinline__ int v_rd_base(int lane) { return ((lane & 3) << 3) | (((lane >> 2) & 3) << 6) | (((lane >> 4) & 1) << 5) | (((lane >> 5) & 1) << 8); }
constexpr int v_rd_off(int d0, int ks, int half) { return d0 * 512 + ks * 4096 + half * 2048; }
__device__ __forceinline__ int crow(int r, int hi) { return (r & 3) + 8 * (r >> 2) + 4 * hi; }
__device__ __forceinline__ unsigned cvtpk(float lo, float hi) { unsigned r; asm volatile("v_cvt_pk_bf16_f32 %0, %1, %2" : "=v"(r) : "v"(lo), "v"(hi)); return r; }
__device__ __forceinline__ bf16x8 pack8(f32x4 a, f32x4 b) { u32x4 w = {cvtpk(a[0], a[1]), cvtpk(a[2], a[3]), cvtpk(b[0], b[1]), cvtpk(b[2], b[3])}; return *reinterpret_cast<bf16x8*>(&w); }
__device__ __forceinline__ bf16x8 load8(const u16* p) { return *reinterpret_cast<const bf16x8*>(p); }
__device__ __forceinline__ bf16x8 ldg8(const u16* ubase, unsigned voff) { return *reinterpret_cast<const bf16x8*>((const char*)ubase + voff); }
__device__ __forceinline__ void mask_tile(f32x16& p0, f32x16& p1, int dq) {
    const float NEG = -__builtin_inff();
#pragma unroll
    for (int r = 0; r < 16; ++r) { const int c = (r & 3) + 8 * (r >> 2); if (dq - c < 0) p0[r] = NEG; if (dq - c - 32 < 0) p1[r] = NEG; }
}
__device__ __forceinline__ void partialSM(f32x16& p0, f32x16& p1, float& m_reg, float& mn, float& alpha, bool off) {
    float pmax = p0[0];
#pragma unroll
    for (int r = 1; r < 16; ++r) pmax = fmaxf(pmax, p0[r]);
#pragma unroll
    for (int r = 0; r < 16; ++r) pmax = fmaxf(pmax, p1[r]);
    { auto rr = __builtin_amdgcn_permlane32_swap(__float_as_uint(pmax), __float_as_uint(pmax), false, false);
      pmax = fmaxf(__uint_as_float(rr[0]), __uint_as_float(rr[1])); }
    if (off) pmax = -__builtin_inff();
    constexpr float C2 = 1.4426950408889634f * SCALE;
    if (__builtin_expect(__all((pmax - m_reg) * SCALE <= THR), 1)) { mn = m_reg; alpha = 1.f; }
    else { mn = fmaxf(m_reg, pmax); alpha = __builtin_amdgcn_exp2f((m_reg - mn) * C2); m_reg = mn; }
    float mnL = -mn * C2; if (off) mnL = -__builtin_inff();
#pragma unroll
    for (int r = 0; r < 16; ++r) p0[r] = fmaf(p0[r], C2, mnL);
#pragma unroll
    for (int r = 0; r < 16; ++r) p1[r] = fmaf(p1[r], C2, mnL);
#pragma unroll
    for (int r = 0; r < 16; ++r) p0[r] = __builtin_amdgcn_exp2f(p0[r]);
}
__device__ __forceinline__ void finishSM(f32x16& p0, f32x16& p1, float alpha, float& l_reg, bf16x8& pa0, bf16x8& pa1, bf16x8& pa2, bf16x8& pa3) {
#pragma unroll
    for (int r = 0; r < 16; ++r) p1[r] = __builtin_amdgcn_exp2f(p1[r]);
    float ps = 0;
#pragma unroll
    for (int r = 0; r < 16; ++r) ps += p0[r];
#pragma unroll
    for (int r = 0; r < 16; ++r) ps += p1[r];
    { auto rr = __builtin_amdgcn_permlane32_swap(__float_as_uint(ps), __float_as_uint(ps), false, false);
      ps = __uint_as_float(rr[0]) + __uint_as_float(rr[1]); }
    l_reg = l_reg * alpha + ps;
#define PK4(P, B_, OUT) do { unsigned a0 = cvtpk(P[B_+0], P[B_+1]), a1 = cvtpk(P[B_+2], P[B_+3]);                          \
        unsigned b0 = cvtpk(P[B_+4], P[B_+5]), b1 = cvtpk(P[B_+6], P[B_+7]);                                             \
        auto r0 = __builtin_amdgcn_permlane32_swap(a0, b0, false, false); auto r1 = __builtin_amdgcn_permlane32_swap(a1, b1, false, false); \
        u32x4 w = {r0[0], r1[0], r0[1], r1[1]}; OUT = *reinterpret_cast<bf16x8*>(&w); } while (0)
    PK4(p0, 0, pa0); PK4(p0, 8, pa1); PK4(p1, 0, pa2); PK4(p1, 8, pa3);
#undef PK4
}
template <int KB>
__device__ __forceinline__ void qkt(f32x16& p0, f32x16& p1, const char* K_lds, int r32, int hi, const bf16x8* qr) {
    p0 = f32x16{}; p1 = f32x16{};
    const char* kb[4];
#pragma unroll
    for (int dd = 0; dd < 4; ++dd) kb[dd] = K_lds + KB * SHM_K + KSWZ(r32, (dd * 16 + hi * 8) * 2);
#pragma unroll
    for (int d0 = 0; d0 < 8; ++d0) { const char* a = kb[d0 & 3] + (d0 >> 2) * 128;
        bf16x8 b0 = *reinterpret_cast<const bf16x8*>(a);
        bf16x8 b1 = *reinterpret_cast<const bf16x8*>(a + 32 * 256);
        p0 = __builtin_amdgcn_mfma_f32_32x32x16_bf16(b0, qr[d0], p0, 0, 0, 0);
        p1 = __builtin_amdgcn_mfma_f32_32x32x16_bf16(b1, qr[d0], p1, 0, 0, 0); }
}
template <int VB>
__device__ __forceinline__ void pv_tile(f32x16* o, int vb0, bf16x8 pa0, bf16x8 pa1, bf16x8 pa2, bf16x8 pa3) {
#define TRRD(dst, off) asm volatile("ds_read_b64_tr_b16 %0, %1 offset:%2" : "=&v"(dst) : "v"(vb0), "i"(off) : "memory")
#define PV_D0(d0) do { s16x4 l0, l1, l2, l3, h0, h1, h2, h3; constexpr int b_ = VB * SHM_V + v_rd_off(d0, 0, 0); \
        TRRD(l0, b_); TRRD(h0, b_ + 2048); TRRD(l1, b_ + 4096); TRRD(h1, b_ + 6144); TRRD(l2, b_ + 8192); TRRD(h2, b_ + 10240); TRRD(l3, b_ + 12288); TRRD(h3, b_ + 14336); \
        asm volatile("s_waitcnt lgkmcnt(0)" ::: "memory"); SBAR();   \
        o[d0] = __builtin_amdgcn_mfma_f32_32x32x16_bf16(pa0, (bf16x8){l0[0], l0[1], l0[2], l0[3], h0[0], h0[1], h0[2], h0[3]}, o[d0], 0, 0, 0);   \
        o[d0] = __builtin_amdgcn_mfma_f32_32x32x16_bf16(pa1, (bf16x8){l1[0], l1[1], l1[2], l1[3], h1[0], h1[1], h1[2], h1[3]}, o[d0], 0, 0, 0);   \
        o[d0] = __builtin_amdgcn_mfma_f32_32x32x16_bf16(pa2, (bf16x8){l2[0], l2[1], l2[2], l2[3], h2[0], h2[1], h2[2], h2[3]}, o[d0], 0, 0, 0);   \
        o[d0] = __builtin_amdgcn_mfma_f32_32x32x16_bf16(pa3, (bf16x8){l3[0], l3[1], l3[2], l3[3], h3[0], h3[1], h3[2], h3[3]}, o[d0], 0, 0, 0); } while (0)
    PV_D0(0); PV_D0(1); PV_D0(2); PV_D0(3);
#undef PV_D0
#undef TRRD
}
struct BlockRef { const u16* Q; const u16* K; const u16* V; const u16* Z; u16* O; const float* KM; int qb; };
struct Seam { bf16x8 qr[8]; bf16x8 st_v0, st_v1, st_k0, st_k1; };
#define ROW(p, k0, rr) ((p) + (size_t)((k0) + (rr)) * LDP + sc)
#define VMW() asm volatile("s_waitcnt vmcnt(0)" ::: "memory")
#define VMWN(n) asm volatile("s_waitcnt vmcnt(%0)" :: "i"(n) : "memory")
#define SLOAD_H(Kp, Vp, k0) do { const u16* vt_ = (Vp) + (size_t)(k0) * LDP; const u16* kt_ = (Kp) + (size_t)(k0) * LDP;            \
                         S.st_v0 = ldg8(vt_, roff); S.st_v1 = ldg8(vt_ + 32 * LDP, roff); S.st_k0 = ldg8(kt_, roff); S.st_k1 = ldg8(kt_ + 32 * LDP, roff); } while (0)
#define SWRITE_HK(bf) do { *(bf16x8*)(K_lds + (bf) * SHM_K + kws) = S.st_k0; *(bf16x8*)(K_lds + (bf) * SHM_K + kws + 32 * 256) = S.st_k1; } while (0)
#define SWRITE_HV(bf) do { *(bf16x8*)(V_lds + (bf) * SHM_V + vst0) = S.st_v0; *(bf16x8*)(V_lds + (bf) * SHM_V + vst1) = S.st_v1; } while (0)
#define SWRITE_H(bf) do { SWRITE_HV(bf); SWRITE_HK(bf); } while (0)
__device__ __forceinline__ void moba_prime(const BlockRef& cur, char* lds, Seam& S) {
    const int tid = threadIdx.x, wid = __builtin_amdgcn_readfirstlane(tid >> 6), lane = tid & 63, r32 = lane & 31, hi = lane >> 5;
    const int sr = tid >> 4, sc = (tid & 15) * 8, kws = KSWZ(sr, sc * 2); char* K_lds = lds + 2 * SHM_V;
    const unsigned roff = (unsigned)(sr * LDP + sc) * 2u, qoff = (unsigned)((wid * QBLK + r32) * LDP + hi * 8) * 2u;
#pragma unroll
    for (int d0 = 0; d0 < 8; ++d0) S.qr[d0] = ldg8(cur.Q + d0 * 16, qoff);
    SLOAD_H(cur.K, cur.V, 0); VMW(); SWRITE_HK(0);
    __syncthreads();
}
__device__ __forceinline__ void moba_block(const BlockRef& cur, const BlockRef& nxt, char* lds, Seam& S) {
    int tid_ = threadIdx.x; asm volatile("" : "+v"(tid_));
    const int tid = tid_, wid = __builtin_amdgcn_readfirstlane(tid >> 6), lane = tid & 63, r32 = lane & 31, hi = lane >> 5;
    const int NT = 4 * (cur.qb + 1), P0 = cur.qb * QB;
    const int qlo = P0 + wid * QBLK, qm = qlo + r32 - 4 * hi;
    char* V_lds = lds; char* K_lds = lds + 2 * SHM_V;
    float* ws = (float*)(lds + OFF_WS) + wid * 64; float* li_l = ws, * al_l = ws + 32;
    float m_reg = -1e30f, l_reg = 0; f32x16 o[4] = {};
    const int sr = tid >> 4, sc = (tid & 15) * 8, vst0 = v_st(sr, sc), vst1 = v_st(32 + sr, sc), kws = KSWZ(sr, sc * 2);
    const int vb0 = (int)(uintptr_t)V_lds + v_rd_base(lane);
    const unsigned roff = (unsigned)(sr * LDP + sc) * 2u, qoff = (unsigned)((wid * QBLK + r32) * LDP + hi * 8) * 2u;
    const u16* Kh = cur.K; const u16* Vh = cur.V;
    unsigned sel = 0xffffu;
    if (cur.qb > 3) {
        char* KMT = lds + OFF_KM;
        { const int row = tid >> 4, c = tid & 15, j = row & 15;
          const float* kp = cur.KM + (size_t)j * 2048 + c * 8;
          const f32x4 a0 = *(const f32x4*)kp, a1 = *(const f32x4*)(kp + 4), b0 = *(const f32x4*)(kp + 128), b1 = *(const f32x4*)(kp + 132);
          const f32x4 x0 = (a0 + b0) * (1.0f / 256.0f), x1 = (a1 + b1) * (1.0f / 256.0f);
          const bf16x8 hv = pack8(x0, x1);
          f32x4 y0, y1;
#pragma unroll
          for (int i = 0; i < 4; ++i) { y0[i] = x0[i] - __uint_as_float(((unsigned)(unsigned short)hv[i]) << 16); y1[i] = x1[i] - __uint_as_float(((unsigned)(unsigned short)hv[4 + i]) << 16); }
          const bf16x8 lv = pack8(y0, y1);
          *(bf16x8*)(KMT + KSWZ(row, c * 16)) = (row >> 4) ? lv : hv; }
        __syncthreads();
        f32x16 g = f32x16{};
#pragma unroll
        for (int d0 = 0; d0 < 8; ++d0) { const bf16x8 a = *reinterpret_cast<const bf16x8*>(KMT + KSWZ(r32, (d0 * 16 + hi * 8) * 2));
            g = __builtin_amdgcn_mfma_f32_32x32x16_bf16(a, S.qr[d0], g, 0, 0, 0); }
        float G[16];
#pragma unroll
        for (int r = 0; r < 8; ++r) { const float gv = g[r] + g[r + 8];
            auto rr = __builtin_amdgcn_permlane32_swap(__float_as_uint(gv), __float_as_uint(gv), false, false);
            G[(r & 3) + 8 * (r >> 2)] = __uint_as_float(rr[0]); G[(r & 3) + 8 * (r >> 2) + 4] = __uint_as_float(rr[1]); }
        sel = 1u << cur.qb;
#pragma unroll
        for (int k = 0; k < 3; ++k) { float best = -__builtin_inff(); int bi = 0;
#pragma unroll
            for (int j = 0; j < 16; ++j) { const float v = (j < cur.qb && !((sel >> j) & 1u)) ? G[j] : -__builtin_inff(); if (v > best) { best = v; bi = j; } }
            sel |= 1u << bi; }
    }
#define OFF(t) (!((sel >> ((t) >> 2)) & 1u))
#define RESC(a) do { if (__any((a) < 1.f)) { if (hi == 0) al_l[r32] = (a); asm volatile("s_waitcnt lgkmcnt(0)" ::: "memory");              \
                     for (int d_ = 0; d_ < 4; ++d_) for (int r = 0; r < 16; ++r) o[d_][r] *= al_l[crow(r, hi)]; } } while (0)
#define KBASE(t) ((t) * KVBLK)
#define MASKT(P0_, P1_, t) do { const int kb_ = KBASE(t); if (kb_ + KVBLK - 1 > qlo) mask_tile(P0_, P1_, qm - kb_); } while (0)
#define SEAM_K0() do { VMWN(8); SWRITE_HK(0); SBAR(); } while (0)
    f32x16 pA0, pA1, pB0, pB1; float mnA, mnB, alA, alB; bf16x8 pa0, pa1, pa2, pa3;
    SWRITE_HV(0); SBAR();
    if (NT > 1) SLOAD_H(Kh, Vh, KBASE(1));
    SBAR(); qkt<0>(pA0, pA1, K_lds, r32, hi, S.qr);
    MASKT(pA0, pA1, 0); partialSM(pA0, pA1, m_reg, mnA, alA, OFF(0));
    if (NT > 1) { VMW(); SWRITE_H(1); }
    __syncthreads();
#define HALF_STEP(PX0, PX1, mnX, alX, PY0, PY1, alY, t, KB, VB, SB) do {                                                      \
        SBAR(); qkt<KB>(PX0, PX1, K_lds, r32, hi, S.qr);                                                                      \
        finishSM(PY0, PY1, alY, l_reg, pa0, pa1, pa2, pa3); SBAR();                                                           \
        if ((t) + 1 < NT) { SLOAD_H(Kh, Vh, KBASE((t) + 1)); SBAR(); }                                                        \
        pv_tile<VB>(o, vb0, pa0, pa1, pa2, pa3); MASKT(PX0, PX1, (t)); partialSM(PX0, PX1, m_reg, mnX, alX, OFF(t));           \
        __syncthreads();                                                                                                      \
        if ((t) + 1 < NT) { VMW(); SWRITE_H(SB); }                                                                            \
        RESC(alX); __syncthreads(); } while (0)
    for (int t = 1; t + 1 < NT; t += 2) {
        HALF_STEP(pB0, pB1, mnB, alB, pA0, pA1, alA, t, 1, 0, 0);
        HALF_STEP(pA0, pA1, mnA, alA, pB0, pB1, alB, t + 1, 0, 1, 1);
    }
    const bool even = (NT & 1) == 0;
    if (even) { SBAR(); qkt<1>(pB0, pB1, K_lds, r32, hi, S.qr); SBAR(); }
    SLOAD_H(nxt.K, nxt.V, 0); SBAR();
#pragma unroll
    for (int d0 = 0; d0 < 8; ++d0) S.qr[d0] = ldg8(nxt.Q + d0 * 16, qoff);
    SBAR();
    finishSM(pA0, pA1, alA, l_reg, pa0, pa1, pa2, pa3); SBAR();
    pv_tile<0>(o, vb0, pa0, pa1, pa2, pa3);
    if (even) { MASKT(pB0, pB1, NT - 1); partialSM(pB0, pB1, m_reg, mnB, alB, OFF(NT - 1)); __syncthreads(); RESC(alB);
        finishSM(pB0, pB1, alB, l_reg, pa0, pa1, pa2, pa3); SBAR(); pv_tile<1>(o, vb0, pa0, pa1, pa2, pa3); }
    SBAR(); SEAM_K0();
    if (hi == 0) li_l[r32] = l_reg; asm volatile("s_waitcnt lgkmcnt(0)" ::: "memory");
    float rli[16];
#pragma unroll
    for (int r = 0; r < 16; ++r) rli[r] = __builtin_amdgcn_rcpf(li_l[crow(r, hi)]);
    __syncthreads();
    char* stg = V_lds + wid * 4096;
    const int srow = lane >> 4, schunk = lane & 15;
#pragma unroll
    for (int h = 0; h < 2; ++h) {
        u32x4 zq[4];
#pragma unroll
        for (int k = 0; k < 4; ++k) zq[k] = *(const u32x4*)(cur.Z + (size_t)(wid * QBLK + 16 * h + 4 * k + srow) * LDP + schunk * 8);
#pragma unroll
        for (int rr = 0; rr < 8; ++rr) { const int r = 8 * h + rr, row = (rr & 3) + 8 * (rr >> 2) + 4 * hi;
#pragma unroll
            for (int d0 = 0; d0 < 4; ++d0) { const float v = o[d0][r] * rli[r];
                *(unsigned short*)(stg + (row * 128 + d0 * 32 + r32) * 2) = (unsigned short)(cvtpk(v, v) & 0xffffu); } }
        asm volatile("s_waitcnt lgkmcnt(0)" ::: "memory");
#pragma unroll
        for (int k = 0; k < 4; ++k) { const u32x4 ov = *(const u32x4*)(stg + ((4 * k + srow) * 128 + schunk * 8) * 2); const u32x4 z = zq[k]; u32x4 w;
#define MZ(a, b) cvtpk(__uint_as_float((a) << 16) * __uint_as_float((b) << 16), __uint_as_float((a) & 0xffff0000u) * __uint_as_float((b) & 0xffff0000u))
            w.x = MZ(ov.x, z.x); w.y = MZ(ov.y, z.y); w.z = MZ(ov.z, z.z); w.w = MZ(ov.w, z.w);
#undef MZ
            *(u32x4*)(cur.O + (size_t)(wid * QBLK + 16 * h + 4 * k + srow) * DM + schunk * 8) = w; }
        asm volatile("s_waitcnt lgkmcnt(0)" ::: "memory");
    }
    __syncthreads();
#undef OFF
#undef RESC
#undef KBASE
#undef MASKT
#undef SEAM_K0
#undef HALF_STEP
}
#undef ROW
#undef VMW
#undef VMWN
#undef SLOAD_H
#undef SWRITE_HK
#undef SWRITE_HV
#undef SWRITE_H
}

#define LAS __attribute__((address_space(3)))
typedef unsigned short u16;
typedef float f32x4_t __attribute__((ext_vector_type(4)));
typedef unsigned u32x4_t __attribute__((ext_vector_type(4)));
typedef unsigned u32x2_t __attribute__((ext_vector_type(2)));
typedef short bf16x8_t __attribute__((ext_vector_type(8)));
__device__ __forceinline__ unsigned pk2(float lo, float hi) { return pg8::cvt_pk_bf16(lo, hi); }
__device__ __forceinline__ float wave_sum(float v) {
#pragma unroll
    for (int o = 1; o < 64; o <<= 1) v += __shfl_xor(v, o);
    return v;
}
__device__ __forceinline__ void transpose_item(const float* W, int N, u16* WT, int ldo, int col_off, LAS float* scr, int item, int lane) {
    const int nblk = N / 64, kb = item / nblk, nb = item % nblk, k0 = 64 * kb, n0 = 64 * nb;
    const float* src = W + (size_t)(k0 + (lane >> 4)) * N + n0 + (lane & 15) * 4;
    f32x4_t v[16];
#pragma unroll
    for (int i = 0; i < 16; ++i) v[i] = *(const f32x4_t*)(src + (size_t)(4 * i) * N);
#pragma unroll
    for (int i = 0; i < 16; ++i) *(LAS f32x4_t*)(scr + (4 * i + (lane >> 4)) * 68 + (((lane & 15) * 4 + 4 * (i >> 1)) & 63)) = v[i];
    asm volatile("s_waitcnt lgkmcnt(0)" ::: "memory");
    const int c = lane & 7;
#pragma unroll
    for (int j = 0; j < 8; ++j) { const int n = (lane >> 3) + 8 * j; const LAS float* s = scr + (8 * c) * 68 + ((n + 4 * c) & 63);
        u32x4_t o; o.x = pk2(s[0 * 68], s[1 * 68]); o.y = pk2(s[2 * 68], s[3 * 68]); o.z = pk2(s[4 * 68], s[5 * 68]); o.w = pk2(s[6 * 68], s[7 * 68]);
        *(u32x4_t*)(WT + (size_t)(n0 + n) * ldo + col_off + k0 + 8 * c) = o; }
    asm volatile("s_waitcnt lgkmcnt(0)" ::: "memory");
}
struct Params {
    const float *x, *norm_g, *w_in, *q_g, *k_g, *sgu_g, *w_s, *b_s, *w_a, *w_b, *w_out;
    float* out; unsigned char* ws; int ph_lo, ph_hi;
};
__device__ __forceinline__ unsigned pack_i8x4(float a, float b, float c, float d) {
    const int ia = __float2int_rn(a), ib = __float2int_rn(b), ic = __float2int_rn(c), id = __float2int_rn(d);
    return (unsigned)(ia & 0xff) | ((unsigned)(ib & 0xff) << 8) | ((unsigned)(ic & 0xff) << 16) | ((unsigned)(id & 0xff) << 24);
}
__device__ __forceinline__ void i8_strip(const Params& p, LAS unsigned char* lds, int strip) {
    const int tid = threadIdx.x, lane = tid & 63, wave = __builtin_amdgcn_readfirstlane(tid >> 6), n = lane & 31, kg = lane >> 5;
    const int c8 = strip * 32, gl = c8 - 5120, wcol = (c8 < 4096 ? c8 : (c8 < 5120 ? c8 + 1024   : ((gl & 128) ? C_GB : C_GA) + 128 * (gl >> 8) + (gl & 127)));
    signed char* W8 = (signed char*)(p.ws + WS_W8); float* WSC = (float*)(p.ws + WS_WSC);
    LAS float* mx = (LAS float*)lds;
    const float* src = p.w_in + (size_t)(256 * wave + kg * 16) * LDP + wcol + n;
    float v[8][16]; float m = 0.f;
#pragma unroll
    for (int c = 0; c < 8; ++c)
#pragma unroll
        for (int i = 0; i < 16; ++i) v[c][i] = src[(size_t)(32 * c + i) * LDP];
#pragma unroll
    for (int c = 0; c < 8; ++c)
#pragma unroll
        for (int i = 0; i < 16; ++i) m = fmaxf(m, fabsf(v[c][i]));
    m = fmaxf(m, __shfl_xor(m, 32));
    if (lane < 32) mx[wave * 32 + lane] = m;
    __syncthreads();
    float cm = mx[n];
#pragma unroll
    for (int w = 1; w < 8; ++w) cm = fmaxf(cm, mx[w * 32 + n]);
    cm = fmaxf(cm, 1e-30f);
    const float inv = 127.0f / cm;
    if (wave == 0 && lane < 32) WSC[c8 + lane] = cm * (1.0f / 127.0f);
    signed char* dst = W8 + (size_t)(c8 + n) * DM + 256 * wave + kg * 16;
#pragma unroll
    for (int c = 0; c < 8; ++c) {
        u32x4_t o; o.x = pack_i8x4(v[c][0] * inv, v[c][1] * inv, v[c][2] * inv, v[c][3] * inv); o.y = pack_i8x4(v[c][4] * inv, v[c][5] * inv, v[c][6] * inv, v[c][7] * inv);
        o.z = pack_i8x4(v[c][8] * inv, v[c][9] * inv, v[c][10] * inv, v[c][11] * inv); o.w = pack_i8x4(v[c][12] * inv, v[c][13] * inv, v[c][14] * inv, v[c][15] * inv);
        *(u32x4_t*)(dst + 32 * c) = o; }
    __syncthreads();
}
__device__ __forceinline__ void phase_prep(const Params& p, LAS unsigned char* lds, int G) {
    const int tid = threadIdx.x, lane = tid & 63, wave = __builtin_amdgcn_readfirstlane(tid >> 6);
    for (int st = blockIdx.x; st < NI8_TILES * 8; st += G) i8_strip(p, lds, st);
    LAS float* scr = (LAS float*)(lds + wave * 17408);
    const int gw = blockIdx.x * 8 + wave, NGW = G * 8;
    u16* Bt1 = (u16*)(p.ws + WS_BT1); u16* Bt3 = (u16*)(p.ws + WS_BT3); u16* Bt4 = (u16*)(p.ws + WS_BT4);
    constexpr int NBFC = NBF_TILES * 256, I_IN = (DM / 64) * (NBFC / 64), I_A = (1024 / 64) * (DM / 64), I_O = (DM / 64) * (DM / 64), NITEMS = I_IN + 2 * I_A + I_O;
    for (int it = NGW - 1 - gw; it < NITEMS; it += NGW) {
        int r = it;
        if (r < I_IN) { const int kb = r / (NBFC / 64), nb = r % (NBFC / 64);
            transpose_item(p.w_in + 4096 + (nb >= 16 ? 1024 : 0), LDP, Bt1, DM, 0, scr, kb * (LDP / 64) + nb, lane); continue; } r -= I_IN;
        if (r < I_A) { transpose_item(p.w_a, DM, Bt3, DM, 0, scr, r, lane); continue; } r -= I_A;
        if (r < I_A) { transpose_item(p.w_b, DM, Bt3, DM, 1024, scr, r, lane); continue; } r -= I_A;
        transpose_item(p.w_out, DM, Bt4, DM, 0, scr, r, lane);
    }
    u16* H = (u16*)p.out;
    unsigned* H8 = (unsigned*)(p.ws + WS_H8); float* HSC = (float*)(p.ws + WS_HSC);
    const f32x4_t* gr = (const f32x4_t*)p.norm_g + lane;
    f32x4_t nx[8];
    if (gw < TOK) { const f32x4_t* xr = (const f32x4_t*)(p.x + (size_t)gw * DM) + lane;
#pragma unroll
        for (int j = 0; j < 8; ++j) nx[j] = xr[64 * j]; }
    for (int m = gw; m < TOK; m += NGW) {
        f32x4_t v[8]; float s0 = 0.f;
#pragma unroll
        for (int j = 0; j < 8; ++j) v[j] = nx[j];
        if (m + NGW < TOK) { const f32x4_t* xr = (const f32x4_t*)(p.x + (size_t)(m + NGW) * DM) + lane;
#pragma unroll
            for (int j = 0; j < 8; ++j) nx[j] = xr[64 * j]; }
#pragma unroll
        for (int j = 0; j < 8; ++j) s0 += (v[j].x * v[j].x + v[j].y * v[j].y) + (v[j].z * v[j].z + v[j].w * v[j].w);
        const float r0 = __builtin_amdgcn_rsqf(wave_sum(s0) * (1.0f / DM) + EPS);
        float mxv = 0.f;
#pragma unroll
        for (int j = 0; j < 8; ++j) { const f32x4_t g = gr[64 * j]; v[j] = v[j] * r0 * g; mxv = fmaxf(fmaxf(mxv, fmaxf(fabsf(v[j].x), fabsf(v[j].y))), fmaxf(fabsf(v[j].z), fabsf(v[j].w))); }
#pragma unroll
        for (int o = 1; o < 64; o <<= 1) mxv = fmaxf(mxv, __shfl_xor(mxv, o));
        mxv = fmaxf(mxv, 1e-30f); const float inv = 127.0f / mxv;
        if (lane == 0) HSC[m] = mxv * (1.0f / 127.0f);
        u32x2_t* o8 = (u32x2_t*)(H + (size_t)m * DM) + lane; unsigned* q8 = H8 + (size_t)m * (DM / 4) + lane;
#pragma unroll
        for (int j = 0; j < 8; ++j) { u32x2_t w; w.x = pk2(v[j].x, v[j].y); w.y = pk2(v[j].z, v[j].w); o8[64 * j] = w;
            q8[64 * j] = pack_i8x4(v[j].x * inv, v[j].y * inv, v[j].z * inv, v[j].w * inv); }
    }
}
struct SguRegs { u32x4_t vw[4]; f32x4_t w0[4], w1[4]; u32x2_t uu[8], zz[8]; float bias; };
__device__ __forceinline__ void sgu_load(const Params& p, int item, SguRegs& R) {
    const int tid = threadIdx.x, lane = tid & 63, wid = __builtin_amdgcn_readfirstlane(tid >> 6), fr = lane & 15, fq = lane >> 4;
    const int g = item & 7; const size_t tok0 = (size_t)(item >> 3) * 128; const int t = 16 * wid + fr;
    const u16* P = (const u16*)(p.ws + WS_PROJ);
#pragma unroll
    for (int ps = 0; ps < 4; ++ps) { const int s = (tid >> 6) * 16 + ((tid & 63) >> 2), cc = 4 * ps + (tid & 3);     R.vw[ps] = *(const u32x4_t*)(P + (tok0 + s) * LDP + C_VB + g * 128 + cc * 8); }
    const float* Wr = p.w_s + ((size_t)g * 128 + t) * 128 + 8 * fq;
#pragma unroll
    for (int ks = 0; ks < 4; ++ks) { if (32 * ks <= 16 * wid + 15) { R.w0[ks] = *(const f32x4_t*)(Wr + 32 * ks); R.w1[ks] = *(const f32x4_t*)(Wr + 32 * ks + 4); } else { R.w0[ks] = (f32x4_t){0.f, 0.f, 0.f, 0.f}; R.w1[ks] = R.w0[ks]; } }
    const u16* up = P + (tok0 + t) * LDP + C_UB + g * 128 + 8 * fq; const u16* zp = P + (tok0 + t) * LDP + C_ZB + g * 128 + 8 * fq;
#pragma unroll
    for (int cp = 0; cp < 4; ++cp) { const u32x4_t a = *(const u32x4_t*)(up + 32 * cp), b = *(const u32x4_t*)(zp + 32 * cp);
        R.uu[2 * cp] = (u32x2_t){a.x, a.y}; R.uu[2 * cp + 1] = (u32x2_t){a.z, a.w}; R.zz[2 * cp] = (u32x2_t){b.x, b.y}; R.zz[2 * cp + 1] = (u32x2_t){b.z, b.w}; }
    R.bias = p.b_s[g * 128 + t];
}
__device__ __forceinline__ void sgu_stage(LAS u16* vgT, const SguRegs& R) {
    const int tid = threadIdx.x;
#pragma unroll
    for (int ps = 0; ps < 4; ++ps) { const int s = (tid >> 6) * 16 + ((tid & 63) >> 2), cc = 4 * ps + (tid & 3);     const u32x4_t w = R.vw[ps];
        LAS u16* d = vgT + (cc * 8) * 136 + s;
        d[0 * 136] = (u16)(w.x & 0xffffu); d[1 * 136] = (u16)(w.x >> 16); d[2 * 136] = (u16)(w.y & 0xffffu); d[3 * 136] = (u16)(w.y >> 16);
        d[4 * 136] = (u16)(w.z & 0xffffu); d[5 * 136] = (u16)(w.z >> 16); d[6 * 136] = (u16)(w.w & 0xffffu); d[7 * 136] = (u16)(w.w >> 16); }
}
__device__ __forceinline__ void sgu_compute(const Params& p, const LAS u16* vgT, int item, const SguRegs& R) {
    const int tid = threadIdx.x, lane = tid & 63, wid = __builtin_amdgcn_readfirstlane(tid >> 6), fr = lane & 15, fq = lane >> 4;
    const int g = item & 7; const size_t tok0 = (size_t)(item >> 3) * 128; const int t = 16 * wid + fr;
    u16* AB = (u16*)p.out;
    f32x4_t acc[8];
#pragma unroll
    for (int ct = 0; ct < 8; ++ct) acc[ct] = (f32x4_t){0.f, 0.f, 0.f, 0.f};
#pragma unroll
    for (int ks = 0; ks < 4; ++ks) {
        if (32 * ks <= 16 * wid + 15) {
            const int s0 = 32 * ks + 8 * fq; f32x4_t a0 = R.w0[ks], a1 = R.w1[ks];
#pragma unroll
            for (int i = 0; i < 4; ++i) { if (s0 + i > t) a0[i] = 0.f; if (s0 + 4 + i > t) a1[i] = 0.f; }
            u32x4_t aw; aw.x = pk2(a0[0], a0[1]); aw.y = pk2(a0[2], a0[3]); aw.z = pk2(a1[0], a1[1]); aw.w = pk2(a1[2], a1[3]);
            const bf16x8_t a = *reinterpret_cast<bf16x8_t*>(&aw);
#pragma unroll
            for (int ct = 0; ct < 8; ++ct) { const bf16x8_t b = *(const LAS bf16x8_t*)(vgT + (32 * (ct >> 1) + 8 * (fr >> 2) + 4 * (ct & 1) + (fr & 3)) * 136 + s0);
                acc[ct] = __builtin_amdgcn_mfma_f32_16x16x32_bf16(b, a, acc[ct], 0, 0, 0); }
        }
    }
    u16* op = AB + (tok0 + t) * DM + 1024 + g * 128 + 8 * fq;
#pragma unroll
    for (int cp = 0; cp < 4; ++cp) { u32x4_t w4;
#pragma unroll
        for (int h = 0; h < 2; ++h) { const int ct = 2 * cp + h; const f32x4_t m = acc[ct] + R.bias;
            const unsigned lo = pk2(m[0] * pg8::bf_lo(R.uu[ct].x) * pg8::bf_lo(R.zz[ct].x), m[1] * pg8::bf_hi(R.uu[ct].x) * pg8::bf_hi(R.zz[ct].x));
            const unsigned hi = pk2(m[2] * pg8::bf_lo(R.uu[ct].y) * pg8::bf_lo(R.zz[ct].y), m[3] * pg8::bf_hi(R.uu[ct].y) * pg8::bf_hi(R.zz[ct].y));
            if (h == 0) { w4.x = lo; w4.y = hi; } else { w4.z = lo; w4.w = hi; } }
        *(u32x4_t*)(op + 32 * cp) = w4; }
}
__device__ __forceinline__ void sgu_phase(const Params& p, LAS unsigned char* lds, int first, int step, int nitems) {
    int it = first; if (it >= nitems) return;
    SguRegs A; sgu_load(p, it & 1023, A); int par = 0;
    for (;;) {
        LAS u16* vgT = (LAS u16*)(lds + par * 36864);
        sgu_stage(vgT, A);
        const int nx = it + step; const bool has = nx < nitems;
        SguRegs B; if (has) sgu_load(p, nx & 1023, B);
        __syncthreads();
        sgu_compute(p, vgT, it & 1023, A);
        if (!has) break;
        A = B; it = nx; par ^= 1;
    }
    __syncthreads();
}

#define XB_TMO      128
#define XB_XCNT(j)  (256  + 64 * (j))
#define XB_XSUB(j)  (1280 + 64 * (j))
#define XB_XGEN(j)  (2304 + 64 * (j))
#define XB_TOP      3328
#define XB_TOPGEN   3392
#define XCD_BAR_WORDS 3456
#define XB_SPIN_CAP (1u << 18)

__device__ __forceinline__ unsigned xb_ld(unsigned* p)              { return __hip_atomic_load(p, __ATOMIC_RELAXED, __HIP_MEMORY_SCOPE_AGENT); }
__device__ __forceinline__ unsigned xb_add(unsigned* p, unsigned v) { return __hip_atomic_fetch_add(p, v, __ATOMIC_RELAXED, __HIP_MEMORY_SCOPE_AGENT); }
__device__ __forceinline__ unsigned xb_xcc_id() { return (unsigned)__builtin_amdgcn_s_getreg((3 << 11) | 20) & 0xFu; }
#define XB_SPIN(cond, bar) do { unsigned _sp = 0; while (cond) { __builtin_amdgcn_s_sleep(1); \
    if ((++_sp & 255u) == 0u) { if (xb_ld(&(bar)[XB_TMO])) break; if (_sp > XB_SPIN_CAP) { atomicAdd(&(bar)[XB_TMO], 1u); break; } } } } while (0)

struct XcdBarrier {
    unsigned* bar; unsigned x;
    volatile LAS unsigned* st;
};

__device__ __forceinline__ XcdBarrier xcd_barrier_post(unsigned* bar, volatile LAS unsigned* st) {
    XcdBarrier b; b.bar = bar; b.x = xb_xcc_id(); b.st = st;
    if (threadIdx.x == 0) (void)xb_add(&bar[XB_XCNT(b.x)], 1u);
    return b;
}
__device__ __forceinline__ void xcd_barrier_complete(unsigned* bar, unsigned x, unsigned& nloc, unsigned& nx) {
    const unsigned G = gridDim.x * gridDim.y * gridDim.z;
    unsigned sum, cnt, mine, sp = 0u;
    for (;;) {
        sum = 0u; cnt = 0u; mine = 0u;
#pragma unroll
        for (unsigned j = 0; j < 16; ++j) { const unsigned c = xb_ld(&bar[XB_XCNT(j)]); sum += c; cnt += (c > 0u) ? 1u : 0u; mine = (j == x) ? c : mine; }
        if (sum == G) break;
        __builtin_amdgcn_s_sleep(1);
        if ((++sp & 255u) == 0u) { if (xb_ld(&bar[XB_TMO])) break; if (sp > XB_SPIN_CAP) { atomicAdd(&bar[XB_TMO], 1u); break; } }
    }
    nloc = mine > 0u ? mine : 1u; nx = cnt > 0u ? cnt : 1u;
}

__device__ __forceinline__ void xcd_barrier(const XcdBarrier& b) {
    asm volatile("s_waitcnt vmcnt(0)" ::: "memory");
    __syncthreads();
    if (threadIdx.x == 0) {
        unsigned* bar = b.bar;
        __builtin_amdgcn_s_waitcnt(0);
        unsigned nloc = b.st[0], nx = b.st[1];
        if (nloc == 0u) { xcd_barrier_complete(bar, b.x, nloc, nx); b.st[0] = nloc; b.st[1] = nx; }
        const unsigned old = xb_add(&bar[XB_XSUB(b.x)], 1u);
        const unsigned gen = old / nloc;
        if (old + 1u == (gen + 1u) * nloc) {
            __builtin_amdgcn_fence(__ATOMIC_RELEASE, "agent");
            asm volatile("s_waitcnt vmcnt(0)" ::: "memory");
            const unsigned og = xb_add(&bar[XB_TOP], 1u);
            const unsigned tg = og / nx;
            if (og + 1u == (tg + 1u) * nx) xb_add(&bar[XB_TOPGEN], 1u);
            else XB_SPIN(xb_ld(&bar[XB_TOPGEN]) == tg, bar);
            __builtin_amdgcn_fence(__ATOMIC_ACQUIRE, "agent");
            xb_add(&bar[XB_XGEN(b.x)], 1u);
            asm volatile("s_waitcnt vmcnt(0)" ::: "memory");
        } else {
            XB_SPIN(xb_ld(&bar[XB_XGEN(b.x)]) == gen, bar);
            __builtin_amdgcn_fence(__ATOMIC_ACQUIRE, "agent");
            asm volatile("s_waitcnt vmcnt(0)" ::: "memory");
        }
    }
    __syncthreads();
}


#define REP_P0 1
#define REP_P1 1
#define REP_ATT 1
#define REP_SGU 1
#define REP_P3 1
#define REP_P4 1
#ifndef SKIP_P0
#define SKIP_P0 0
#endif
#ifndef SKIP_P1
#define SKIP_P1 0
#endif
#ifndef SKIP_P2
#define SKIP_P2 0
#endif
#ifndef SKIP_P3
#define SKIP_P3 0
#endif
#ifndef SKIP_P4
#define SKIP_P4 0
#endif
__global__ void __launch_bounds__(512, 2) hybrid_fwd(Params p) {
    extern __shared__ __attribute__((aligned(16))) unsigned char lds_raw[];
    LAS unsigned char* lds = (LAS unsigned char*)lds_raw;
    cg::grid_group grid = cg::this_grid();
    const int G = gridDim.x, lo = p.ph_lo, hi = p.ph_hi;
    const u16* Bt1 = (const u16*)(p.ws + WS_BT1); const u16* Bt3 = (const u16*)(p.ws + WS_BT3); const u16* Bt4 = (const u16*)(p.ws + WS_BT4);
    u16* PROJ = (u16*)(p.ws + WS_PROJ); u16* MRG = (u16*)(p.ws + WS_MRG); float* KMP = (float*)(p.ws + WS_KMP); u16* HAB = (u16*)p.out;
#define IN(k) (lo <= (k) && (k) < hi)
#define SEAM(k) do { if (IN(k) && IN((k) + 1)) xcd_barrier(bar); } while (0)
    if (threadIdx.x < 4) ((LAS unsigned*)(lds + LDS_MISC))[threadIdx.x] = 0u;
    __syncthreads();
    XcdBarrier bar; bar.bar = (unsigned*)(p.ws + WS_BAR); bar.x = 0; bar.st = nullptr;
    if (hi - lo > 1) bar = xcd_barrier_post((unsigned*)(p.ws + WS_BAR), (volatile LAS unsigned*)(lds + LDS_MISC));
    if (hi > 99) grid.sync();
    if (IN(0) && !SKIP_P0) {
#pragma unroll 1
        for (int rep = 0; rep < REP_P0; ++rep) { phase_prep(p, lds, G); __syncthreads(); } }
    SEAM(0);
    if (IN(1) && !SKIP_P1) {
        const float* HSC = (const float*)(p.ws + WS_HSC); const float* WSC = (const float*)(p.ws + WS_WSC);
        {
            pg8::Gemm g{(const u16*)(p.ws + WS_H8), (const u16*)(p.ws + WS_W8), TOK, NI8_TILES * 256, DM / 2}; pg8::StaticOrder S; S.init(TOK, NI8_TILES * 256, G, (int)blockIdx.x, REP_P1, 7);
            pg8::EpiProj<true> E{PROJ, p.q_g, p.k_g, p.sgu_g, KMP, (LAS float*)(lds + LDS_XCH), HSC, WSC};
            pg8::gemm_phase<pg8::EpiProj<true>, pg8::StaticOrder, true, true, true>(lds, g, S, E);
        }
        {
            pg8::Gemm g{HAB, Bt1, TOK, NBF_TILES * 256, DM}; pg8::StaticOrder S; S.init(TOK, NBF_TILES * 256, G, (int)blockIdx.x, REP_P1, 7);
            pg8::EpiProj<false> E{PROJ, p.q_g, p.k_g, p.sgu_g, KMP, (LAS float*)(lds + LDS_XCH), HSC, WSC};
            pg8::gemm_phase<pg8::EpiProj<false>, pg8::StaticOrder, true, true, false>(lds, g, S, E);
        }
    }
    SEAM(1);
    if (IN(2) && !SKIP_P2) {
#ifndef SKIP_SGU
        sgu_phase(p, lds, (int)blockIdx.x, G, NB * 32 * 8 * REP_SGU);
#endif
#ifndef SKIP_ATT
        for (int L0 = blockIdx.x; L0 < 256 * REP_ATT; L0 += G) { const int Lr = L0 & 255, L = ((Lr & 7) << 5) | (Lr >> 3);
            const int bh = L >> 3, xx = L & 7, b = bh >> 3, h = bh & 7;
            att::BlockRef r0, r1;
            const u16* Pb = PROJ + (size_t)b * SEQ * LDP + h * HD;
            r0.K = r1.K = Pb + C_K; r0.V = r1.V = Pb + C_V; r0.KM = r1.KM = KMP + ((size_t)(b * 16) * 8 + h) * 256;
            r0.qb = xx; r1.qb = 15 - xx;
            r0.Q = Pb + (size_t)r0.qb * 256 * LDP + C_Q; r0.Z = Pb + (size_t)r0.qb * 256 * LDP + C_ZA; r0.O = HAB + ((size_t)b * SEQ + r0.qb * 256) * DM + h * HD;
            r1.Q = Pb + (size_t)r1.qb * 256 * LDP + C_Q; r1.Z = Pb + (size_t)r1.qb * 256 * LDP + C_ZA; r1.O = HAB + ((size_t)b * SEQ + r1.qb * 256) * DM + h * HD;
            att::Seam S;
            att::moba_prime(r0, (char*)lds_raw, S);
            att::BlockRef cur = r0;
#pragma unroll 1
            for (int pass = 0; pass < 2; ++pass) { att::moba_block(cur, r1, (char*)lds_raw, S); cur = r1; }
            asm volatile("s_waitcnt vmcnt(0)" ::: "memory"); __syncthreads();
        }
#endif
    }
    SEAM(2);
    if (IN(3) && !SKIP_P3) {
        pg8::Gemm g{HAB, Bt3, TOK, DM, DM}; pg8::StaticOrder S; S.init(TOK, DM, G, (int)blockIdx.x, REP_P3, 7);
        pg8::EpiMerge E{PROJ, MRG};
        pg8::gemm_phase<pg8::EpiMerge, pg8::StaticOrder, true, true>(lds, g, S, E);
    }
    SEAM(3);
    if (IN(4) && !SKIP_P4) {
        pg8::Gemm g{MRG, Bt4, TOK, DM, DM}; pg8::StaticOrder S; S.init(TOK, DM, G, (int)blockIdx.x, REP_P4, 7);
        pg8::EpiOut E{p.x, p.out};
        pg8::gemm_phase<pg8::EpiOut, pg8::StaticOrder, true, true>(lds, g, S, E);
    }
#undef IN
#undef SEAM
}

#ifndef N_LAUNCHES
#define N_LAUNCHES 1
#endif
extern "C" void kernel_launch(void* const* d_in, const int* in_sizes, int n_in, void* d_out, int out_size, void* d_ws, size_t ws_size, hipStream_t stream) {
    static int grid = 0;
    if (grid == 0) {
        if (n_in != 11 || in_sizes[0] != TOK * DM || out_size != TOK * DM || ws_size < WS_END) { fprintf(stderr, "kernel_launch: unexpected shapes (n_in %d in0 %d out %d ws %zu need %zu)\n", n_in, n_in > 0 ? in_sizes[0] : -1, out_size, ws_size, (size_t)WS_END); grid = -1; return; }
        int dev = 0, cus = 0, per_cu = 0;
        (void)hipGetDevice(&dev); (void)hipDeviceGetAttribute(&cus, hipDeviceAttributeMultiprocessorCount, dev);
        if (hipFuncSetAttribute((const void*)hybrid_fwd, hipFuncAttributeMaxDynamicSharedMemorySize, LDS_TOTAL) != hipSuccess) { fprintf(stderr, "kernel_launch: hipFuncSetAttribute failed\n"); grid = -1; return; }
        if (hipOccupancyMaxActiveBlocksPerMultiprocessor(&per_cu, (const void*)hybrid_fwd, 512, LDS_TOTAL) != hipSuccess || per_cu < 1) { fprintf(stderr, "kernel_launch: occupancy query says %d blocks/CU\n", per_cu); grid = -1; return; }
        if (per_cu > 1) per_cu = 1;
        grid = cus * per_cu;
    }
    if (grid < 0) return;
    Params p{};
    p.x = (const float*)d_in[0]; p.norm_g = (const float*)d_in[1]; p.w_in = (const float*)d_in[2]; p.q_g = (const float*)d_in[3]; p.k_g = (const float*)d_in[4];
    p.sgu_g = (const float*)d_in[5]; p.w_s = (const float*)d_in[6]; p.b_s = (const float*)d_in[7]; p.w_a = (const float*)d_in[8]; p.w_b = (const float*)d_in[9]; p.w_out = (const float*)d_in[10];
    p.out = (float*)d_out; p.ws = (unsigned char*)d_ws;
#if N_LAUNCHES == 1
    if (hipMemsetAsync((char*)d_ws + WS_BAR, 0, 16384, stream) != hipSuccess) { fprintf(stderr, "kernel_launch: barrier memset failed\n"); return; }
    p.ph_lo = 0; p.ph_hi = 5;
    void* args[] = {&p};
    hipError_t e = hipLaunchCooperativeKernel((const void*)hybrid_fwd, dim3(grid), dim3(512), args, LDS_TOTAL, stream);
    if (e != hipSuccess) fprintf(stderr, "cooperative launch failed: %s (grid %d)\n", hipGetErrorString(e), grid);
#else
    for (int ph = 0; ph < 5; ++ph) { p.ph_lo = ph; p.ph_hi = ph + 1; hipLaunchKernelGGL(hybrid_fwd, dim3(grid), dim3(512), LDS_TOTAL, stream, p); }
#endif
}
```

```cpp
#include <hip/hip_runtime.h>
#include <hip/hip_cooperative_groups.h>
#include <hip/hip_bf16.h>
#include <cstdio>
#include <cstdint>
namespace cg = cooperative_groups;

constexpr int DM = 2048, NB = 4, SEQ = 4096, TOK = NB * SEQ, NH = 8, HD = 128, LDP = 11264;
constexpr int C_Q = 0, C_K = 1024, C_V = 2048, C_ZA = 3072, C_UB = 4096, C_VB = 5120, C_ZB = 6144, C_GA = 7168, C_GB = 9216;
constexpr float EPS = 1e-6f;
constexpr size_t WS_BT1 = 0;
constexpr size_t WS_BT3 = WS_BT1 + (size_t)LDP * DM * 2;
constexpr size_t WS_BT4 = WS_BT3 + (size_t)DM * DM * 2;
constexpr size_t WS_PROJ = WS_BT4 + (size_t)DM * DM * 2;
constexpr size_t WS_MRG = WS_PROJ + (size_t)TOK * LDP * 2;
constexpr size_t WS_KMP = WS_MRG + (size_t)TOK * DM * 2;
constexpr size_t WS_H8 = WS_KMP + (size_t)64 * 8 * 2 * 128 * 4;
constexpr size_t WS_HSC = WS_H8 + (size_t)TOK * DM;
constexpr size_t WS_WSC = WS_HSC + (size_t)TOK * 4;
constexpr size_t WS_BAR = WS_WSC + (size_t)9216 * 4;
constexpr size_t WS_END = WS_BAR + 16384;
constexpr int NI8_TILES = 36, NBF_TILES = 8;
constexpr size_t WS_W8 = WS_BT1 + (size_t)NBF_TILES * 256 * DM * 2;
constexpr int LDS_XCH = 131072;
constexpr int LDS_MISC = LDS_XCH + 10240;
constexpr int LDS_TOTAL = LDS_MISC + 16;

namespace pg8 {
#define PG8_LAS __attribute__((address_space(3)))
typedef unsigned short bf16_t;
typedef short bf16x8 __attribute__((ext_vector_type(8)));
typedef float f32x4 __attribute__((ext_vector_type(4)));
typedef unsigned u32x4 __attribute__((ext_vector_type(4)));
typedef int i32x4 __attribute__((ext_vector_type(4)));
typedef float f32x2 __attribute__((ext_vector_type(2)));
constexpr int BM = 256, BK = 64, HALF = 128, HTB = HALF * BK * 2  , STAGE_BYTES = 8 * HTB, NXCD = 8, WGM = 8;

__host__ __device__ __forceinline__ int lds_byte(int r, int c) { const int st = (r >> 4) * 2 + (c >> 5), rr = r & 15, cc = c & 31, ob = rr * 64 + cc * 2; return st * 1024 + (ob ^ (((ob >> 9) & 1) << 5)); }
__host__ __device__ __forceinline__ void stage_rc(int b, int& R, int& C) { const int st = b / 1024, sb = b % 1024, swz = sb ^ (((sb >> 9) & 1) << 5); R = (st >> 1) * 16 + swz / 64; C = (st & 1) * 32 + (swz % 64) / 2; }
__host__ __device__ __forceinline__ int perm32(int rho) { const int n = rho >> 4, i = rho & 15; return 8 * (i >> 2) + 4 * n + (i & 3); }

struct Unit { int pm, pn; };
struct Gemm { const bf16_t* A; const bf16_t* Bt; int M, N, K; };

struct StaticOrder {
    int nM, nN, nwg, G, c, rep, wgm;
    __host__ __device__ void init(int M, int N, int G_, int c_, int rep_ = 1, int wgm_ = WGM) { nM = M / BM; nN = N / BM; nwg = nM * nN; G = G_; c = c_; rep = rep_; wgm = wgm_; }
    __host__ __device__ bool next(int i, Unit& u) const {
        long L = (long)i * G + c; if (L >= (long)nwg * rep) return false; L %= nwg;
        int wgid = (int)L; { const int q = nwg / NXCD, r = nwg % NXCD, xcd = wgid % NXCD, off = wgid / NXCD; wgid = (xcd < r ? xcd * (q + 1) : r * (q + 1) + (xcd - r) * q) + off; }
        const int nig = wgm * nN, gid = wgid / nig, fm = gid * wgm, gsz = (nM - fm) < wgm ? (nM - fm) : wgm;
        u.pm = fm + ((wgid % nig) % gsz); u.pn = (wgid % nig) / gsz; return true;
    }
    __device__ __forceinline__ void a_ready(const Unit&) const {}
    __device__ __forceinline__ void done(const Unit&) const {}
};

__device__ __forceinline__ unsigned cvt_pk_bf16(float lo, float hi) { unsigned r; asm volatile("v_cvt_pk_bf16_f32 %0, %1, %2" : "=v"(r) : "v"(lo), "v"(hi)); return r; }
__device__ __forceinline__ float bf_lo(unsigned w) { return __uint_as_float(w << 16); }
__device__ __forceinline__ float bf_hi(unsigned w) { return __uint_as_float(w & 0xffff0000u); }
__device__ __forceinline__ float sigmoid_f(float x) { return __builtin_amdgcn_rcpf(1.0f + __builtin_amdgcn_exp2f(-1.4426950408889634f * x)); }
__device__ __forceinline__ float silu_f(float x) { return x * sigmoid_f(x); }
__device__ __forceinline__ float gelu_f(float x) { const float u = 0.7978845608028654f * (x + 0.044715f * x * x * x); return x * sigmoid_f(2.0f * u); }

template <bool I8E> struct EpiProj {
    static constexpr bool PERM = true, AFTER_DRAIN = false, MIDHOOK = false;
    bf16_t* P; const float* qg; const float* kg; const float* sg; float* kmp; PG8_LAS float* xch;
    const float* hs; const float* wsc;
    __device__ __forceinline__ void mid(f32x4 (&)[2][2][4][2], const Unit&, int, int, int, int) const {}
    __device__ __forceinline__ void operator()(f32x4 (&acc)[2][2][4][2], const Unit& u, int wr, int wc, int fr, int fq) const {
        const int pn = I8E ? (u.pn < 16 ? u.pn : (u.pn < 20 ? u.pn + 4 : 28)) : (u.pn < 4 ? u.pn + 16 : u.pn + 20), colw = wc * 32 + 8 * fq;
        int lid = fr | (fq << 4); if constexpr (I8E) asm volatile("" : "+v"(lid));
        const int colw2 = wc * 32 + 8 * (lid >> 4), fr2 = lid & 15;
        if constexpr (I8E) {
            const float* hp = hs + u.pm * BM + wr * 64 + fr2; const float* wp = wsc + u.pn * BM + colw2;
            f32x4 cs[2][2]; float rs[2][4];
#pragma unroll
            for (int bj = 0; bj < 2; ++bj) { cs[bj][0] = *(const f32x4*)(wp + bj * HALF); cs[bj][1] = *(const f32x4*)(wp + bj * HALF + 4); }
#pragma unroll
            for (int ai = 0; ai < 2; ++ai)
#pragma unroll
                for (int m = 0; m < 4; ++m) rs[ai][m] = hp[ai * HALF + m * 16];
#pragma unroll
            for (int ai = 0; ai < 2; ++ai)
#pragma unroll
                for (int m = 0; m < 4; ++m)
#pragma unroll
                    for (int bj = 0; bj < 2; ++bj) { acc[ai][bj][m][0] = acc[ai][bj][m][0] * (cs[bj][0] * rs[ai][m]); acc[ai][bj][m][1] = acc[ai][bj][m][1] * (cs[bj][1] * rs[ai][m]); }
        }
        int act = 0; const float* gain = nullptr; bool km = false;
        if (pn < 4) { gain = qg; } else if (pn < 8) { gain = kg; km = true; } else if (pn < 12) { } else if (pn < 16) { act = 1; }
        else if (pn < 20) { act = 2; } else if (pn < 24) { act = 2; gain = sg; } else if (pn < 28) { act = 1; } else { act = 3; }
        const bool gate = I8E && u.pn >= 20;
        const int colbase = gate ? C_GA + 128 * (u.pn - 20) : pn * BM, bjoff = gate ? (C_GB - C_GA) : HALF;
        bf16_t* ubase = P + (size_t)(u.pm * BM) * LDP + colbase;
        const unsigned loff = (unsigned)((wr * 64 + fr2) * LDP + colw2) * 2u;
#define EPI_STORE_GROUP(ai, m) do { char* rowp_ = (char*)(ubase + ((ai) * HALF + (m) * 16) * LDP) + loff; _Pragma("unroll") for (int bj_ = 0; bj_ < 2; ++bj_) { \
            const f32x4 v0_ = acc[ai][bj_][m][0], v1_ = acc[ai][bj_][m][1]; u32x4 w_; w_.x = cvt_pk_bf16(v0_[0], v0_[1]); w_.y = cvt_pk_bf16(v0_[2], v0_[3]); w_.z = cvt_pk_bf16(v1_[0], v1_[1]); w_.w = cvt_pk_bf16(v1_[2], v1_[3]); \
            *(u32x4*)(rowp_ + bj_ * bjoff * 2) = w_; } } while (0)
        if (act != 0) {
            const float L2E = -1.4426950408889634f;
            const float c1 = ((act == 2) ? 1.5957691216057308f : 1.0f) * L2E, c3 = ((act == 2) ? 0.07135481627260025f : 0.0f) * L2E, ma = (act == 3) ? 0.0f : 1.0f, mb = (act == 3) ? 1.0f : 0.0f;
            const f32x2 C1 = {c1, c1}, C3 = {c3, c3}, MA = {ma, ma}, MB = {mb, mb}, ONE = {1.0f, 1.0f};
#pragma unroll
            for (int ai = 0; ai < 2; ++ai)
#pragma unroll
                for (int m = 0; m < 4; ++m) { f32x4 dB[2];
#pragma unroll
                    for (int bj = 0; bj < 2; ++bj)
#pragma unroll
                        for (int n = 0; n < 2; ++n) {
#pragma unroll
                            for (int j = 0; j < 4; j += 2) { const f32x2 x = {acc[ai][bj][m][n][j], acc[ai][bj][m][n][j + 1]};
                                const f32x2 t = x * ((x * x) * C3 + C1); f32x2 e; e.x = __builtin_amdgcn_exp2f(t.x); e.y = __builtin_amdgcn_exp2f(t.y);
                                const f32x2 d = e + ONE; f32x2 r; r.x = __builtin_amdgcn_rcpf(d.x); r.y = __builtin_amdgcn_rcpf(d.y);
                                if (bj == 1) { dB[n][j] = d.x; dB[n][j + 1] = d.y; }
                                const f32x2 o = (x * MA + MB) * r; acc[ai][bj][m][n][j] = o.x; acc[ai][bj][m][n][j + 1] = o.y; }
                            __builtin_amdgcn_sched_barrier(0); }
                    if constexpr (I8E) if (gate) {
#pragma unroll
                        for (int n = 0; n < 2; ++n)
#pragma unroll
                            for (int j = 0; j < 4; ++j) acc[ai][0][m][n][j] = acc[ai][0][m][n][j] * fminf(dB[n][j], 1e30f); }
                    if (!gain) { EPI_STORE_GROUP(ai, m); __builtin_amdgcn_sched_barrier(0); }
                }
        }
        unsigned xbo = (unsigned)(((wr * 64 + fr) * 2) * 4 + wc) * 4u; asm volatile("" : "+v"(xbo));
        PG8_LAS float* xb = (PG8_LAS float*)((PG8_LAS char*)xch + xbo);
        if (gain) {
#pragma unroll
            for (int ai = 0; ai < 2; ++ai)
#pragma unroll
                for (int m = 0; m < 4; ++m)
#pragma unroll
                    for (int bj = 0; bj < 2; ++bj) {
                        const f32x4 a = acc[ai][bj][m][0], b = acc[ai][bj][m][1];
                        float s = (a[0] * a[0] + a[1] * a[1]) + (a[2] * a[2] + a[3] * a[3]) + (b[0] * b[0] + b[1] * b[1]) + (b[2] * b[2] + b[3] * b[3]);
                        s += __shfl_xor(s, 16); s += __shfl_xor(s, 32);
                        if (fq == 0) xb[((ai * HALF + m * 16) * 2 + bj) * 4] = s;
                    }
            asm volatile("s_waitcnt lgkmcnt(0)" ::: "memory"); __builtin_amdgcn_s_barrier(); asm volatile("" ::: "memory");
            {
                const int t = threadIdx.x; const f32x4 pp = *(const PG8_LAS f32x4*)(xch + t * 4);
                xch[2048 + t] = __builtin_amdgcn_rsqf(((pp[0] + pp[1]) + (pp[2] + pp[3])) * (1.0f / 128.0f) + EPS); }
            asm volatile("s_waitcnt lgkmcnt(0)" ::: "memory"); __builtin_amdgcn_s_barrier(); asm volatile("" ::: "memory");
            const f32x4 g0 = *(const f32x4*)(gain + colw2), g1 = *(const f32x4*)(gain + colw2 + 4);
#pragma unroll
            for (int ai = 0; ai < 2; ++ai)
#pragma unroll
                for (int m = 0; m < 4; ++m) {
                    const f32x2 rs = *(const PG8_LAS f32x2*)(xch + 2048 + (ai * HALF + wr * 64 + m * 16 + fr) * 2);
                    acc[ai][0][m][0] = acc[ai][0][m][0] * rs[0] * g0; acc[ai][0][m][1] = acc[ai][0][m][1] * rs[0] * g1;
                    acc[ai][1][m][0] = acc[ai][1][m][0] * rs[1] * g0; acc[ai][1][m][1] = acc[ai][1][m][1] * rs[1] * g1;
                }
            if (km) {
#pragma unroll
                for (int bj = 0; bj < 2; ++bj)
#pragma unroll
                    for (int n = 0; n < 2; ++n) {
                        f32x4 cs = (f32x4){0.f, 0.f, 0.f, 0.f};
#pragma unroll
                        for (int ai = 0; ai < 2; ++ai)
#pragma unroll
                            for (int m = 0; m < 4; ++m) cs += acc[ai][bj][m][n];
#pragma unroll
                        for (int j = 0; j < 4; ++j) { float v = cs[j]; v += __shfl_xor(v, 1); v += __shfl_xor(v, 2); v += __shfl_xor(v, 4); v += __shfl_xor(v, 8); cs[j] = v; }
                        if (fr2 == 0) *(f32x4*)(kmp + ((size_t)(u.pm * 8 + (pn - 4) * 2 + bj) * 2 + wr) * 128 + colw2 + 4 * n) = cs;
                    }
            }
        }
        if (gain || act == 0) {
#pragma unroll
            for (int ai = 0; ai < 2; ++ai)
#pragma unroll
                for (int m = 0; m < 4; ++m) EPI_STORE_GROUP(ai, m);
        }
#undef EPI_STORE_GROUP
    }
};
struct EpiMerge {
    static constexpr bool PERM = true, AFTER_DRAIN = false, MIDHOOK = true;
    const bf16_t* P; bf16_t* O;
    __device__ __forceinline__ void mid(f32x4 (&acc)[2][2][4][2], const Unit& u, int wr, int wc, int fr, int fq) const {
        const bf16_t* ubase = P + (size_t)(u.pm * BM) * LDP + u.pn * BM + C_GA;
        unsigned loff = (unsigned)((wr * 64 + fr) * LDP + wc * 32 + 8 * fq) * 2u; asm volatile("" : "+v"(loff));
#pragma unroll
        for (int ai = 0; ai < 2; ++ai) {
            u32x4 a[4][2];
#pragma unroll
            for (int m = 0; m < 4; ++m)
#pragma unroll
                for (int bj = 0; bj < 2; ++bj) a[m][bj] = *(const u32x4*)((const char*)(ubase + (ai * HALF + m * 16) * LDP) + loff + bj * HALF * 2);
#pragma unroll
            for (int m = 0; m < 4; ++m)
#pragma unroll
                for (int bj = 0; bj < 2; ++bj) { const u32x4 w = a[m][bj]; f32x4 r0, r1;
                    r0[0] = bf_lo(w.x); r0[1] = bf_hi(w.x); r0[2] = bf_lo(w.y); r0[3] = bf_hi(w.y); r1[0] = bf_lo(w.z); r1[1] = bf_hi(w.z); r1[2] = bf_lo(w.w); r1[3] = bf_hi(w.w);
                    acc[ai][bj][m][0] *= r0; acc[ai][bj][m][1] *= r1; }
            asm volatile("" ::: "memory"); }
    }
    __device__ __forceinline__ void operator()(f32x4 (&acc)[2][2][4][2], const Unit& u, int wr, int wc, int fr, int fq) const {
        const bf16_t* ubase = P + (size_t)(u.pm * BM) * LDP + u.pn * BM + C_GB;
        bf16_t* obase = O + (size_t)(u.pm * BM) * DM + u.pn * BM;
        const unsigned loff = (unsigned)((wr * 64 + fr) * LDP + wc * 32 + 8 * fq) * 2u, ooff = (unsigned)((wr * 64 + fr) * DM + wc * 32 + 8 * fq) * 2u;
#pragma unroll
        for (int ai = 0; ai < 2; ++ai) {
            u32x4 bq[4][2];
#pragma unroll
            for (int m = 0; m < 4; ++m)
#pragma unroll
                for (int bj = 0; bj < 2; ++bj) bq[m][bj] = *(const u32x4*)((const char*)(ubase + (ai * HALF + m * 16) * LDP) + loff + bj * HALF * 2);
#pragma unroll
            for (int m = 0; m < 4; ++m) { char* orow = (char*)(obase + (ai * HALF + m * 16) * DM) + ooff;
#pragma unroll
                for (int bj = 0; bj < 2; ++bj) { const u32x4 b = bq[m][bj];
                    const f32x4 v0 = acc[ai][bj][m][0], v1 = acc[ai][bj][m][1];
                    u32x4 w; w.x = cvt_pk_bf16(v0[0] * fmaxf(bf_lo(b.x), 1e-30f), v0[1] * fmaxf(bf_hi(b.x), 1e-30f)); w.y = cvt_pk_bf16(v0[2] * fmaxf(bf_lo(b.y), 1e-30f), v0[3] * fmaxf(bf_hi(b.y), 1e-30f));
                    w.z = cvt_pk_bf16(v1[0] * fmaxf(bf_lo(b.z), 1e-30f), v1[1] * fmaxf(bf_hi(b.z), 1e-30f)); w.w = cvt_pk_bf16(v1[2] * fmaxf(bf_lo(b.w), 1e-30f), v1[3] * fmaxf(bf_hi(b.w), 1e-30f));
                    *(u32x4*)(orow + bj * HALF * 2) = w; } }
            asm volatile("" ::: "memory"); }
    }
};
struct EpiOut {
    static constexpr bool PERM = false, AFTER_DRAIN = false, MIDHOOK = false;
    const float* __restrict__ X; float* __restrict__ O;
    __device__ __forceinline__ void mid(f32x4 (&)[2][2][4][2], const Unit&, int, int, int, int) const {}
    __device__ __forceinline__ void operator()(f32x4 (&acc)[2][2][4][2], const Unit& u, int wr, int wc, int fr, int fq) const {
        const size_t r0i = (size_t)(u.pm * BM + wr * 64 + fr); const int col = u.pn * BM + wc * 32 + 4 * fq;
        f32x4 xq[4][2][2][2];
#define EO_LOAD(q) do { _Pragma("unroll") for (int mm = 0; mm < 2; ++mm) _Pragma("unroll") for (int bj = 0; bj < 2; ++bj) _Pragma("unroll") for (int n = 0; n < 2; ++n) \
            xq[q][mm][bj][n] = *(const f32x4*)(X + (r0i + ((q) >> 1) * HALF + (2 * ((q) & 1) + mm) * 16) * DM + col + bj * HALF + 16 * n); } while (0)
#define EO_STORE(q) do { _Pragma("unroll") for (int mm = 0; mm < 2; ++mm) _Pragma("unroll") for (int bj = 0; bj < 2; ++bj) _Pragma("unroll") for (int n = 0; n < 2; ++n) \
            *(f32x4*)(O + (r0i + ((q) >> 1) * HALF + (2 * ((q) & 1) + mm) * 16) * DM + col + bj * HALF + 16 * n) = xq[q][mm][bj][n] + acc[(q) >> 1][bj][2 * ((q) & 1) + mm][n]; } while (0)
        EO_LOAD(0); EO_LOAD(1); asm volatile("" ::: "memory");
        EO_LOAD(2); asm volatile("" ::: "memory"); EO_STORE(0); asm volatile("" ::: "memory");
        EO_LOAD(3); asm volatile("" ::: "memory"); EO_STORE(1); asm volatile("" ::: "memory");
        EO_STORE(2); asm volatile("" ::: "memory"); EO_STORE(3);
#undef EO_LOAD
#undef EO_STORE
    }
};

template <class Epi, class Sched, bool ALIGN_EPI = false, bool SP2 = false, bool I8 = false>
__device__ __forceinline__ void gemm_phase(PG8_LAS unsigned char* lds, const Gemm g, const Sched& S, const Epi& E) {
    int tid_ = threadIdx.x; asm volatile("" : "+v"(tid_));
    const int tid = tid_, wid = __builtin_amdgcn_readfirstlane(tid >> 6), lane = tid & 63, wr = wid >> 2, wc = wid & 3, fr = lane & 15, fq = lane >> 4;
    const int K = g.K, nt = K / BK;
    unsigned voffA[2], voffB[2];
#pragma unroll
    for (int i = 0; i < 2; ++i) { int R, C; stage_rc(tid * 16 + i * 8192, R, C); const int Rb = Epi::PERM ? ((R & ~31) + perm32(R & 31)) : R;
        voffA[i] = (unsigned)(R * K + C) * 2u; voffB[i] = (unsigned)(Rb * K + C) * 2u; }
    const size_t kstep = (size_t)(BK * 2);
    const size_t hstep = (size_t)HALF * K * 2;
    const size_t tstep = 2 * hstep;
    const unsigned ldsw = (unsigned)wid * 1024u;
    const int aoff = lds_byte(wr * 64 + fr, fq * 8), boff = lds_byte(wc * 32 + fr, fq * 8);
#define PG8_SA(b, h) (((b) * 2 + (h)) * HTB)
#define PG8_SB(b, h) ((4 + (b) * 2 + (h)) * HTB)
#define PG8_STAGE(bufoff, gbase, voff) do { _Pragma("unroll") for (int _i = 0; _i < 2; ++_i) \
        __builtin_amdgcn_global_load_lds((const unsigned*)((const char*)(gbase) + (voff)[_i]), (PG8_LAS unsigned*)(lds + (bufoff) + ldsw + _i * 8192), 16, 0, 0); } while (0)
#define PG8_LDA(dst, b, h) do { _Pragma("unroll") for (int m = 0; m < 4; ++m) _Pragma("unroll") for (int k = 0; k < 2; ++k) dst[m][k] = *(const PG8_LAS bf16x8*)(lds + PG8_SA(b, h) + aoff + m * 2048 + k * 1024); } while (0)
#define PG8_LDB(dst, b, h) do { _Pragma("unroll") for (int n = 0; n < 2; ++n) _Pragma("unroll") for (int k = 0; k < 2; ++k) dst[n][k] = *(const PG8_LAS bf16x8*)(lds + PG8_SB(b, h) + boff + n * 2048 + k * 1024); } while (0)
#define PG8_MMA(ai, bj, At, Bt) do { __builtin_amdgcn_s_setprio(1); _Pragma("unroll") for (int m = 0; m < 4; ++m) _Pragma("unroll") for (int n = 0; n < 2; ++n) _Pragma("unroll") for (int k = 0; k < 2; ++k) \
        { if constexpr (I8) acc[ai][bj][m][n] = __builtin_bit_cast(f32x4, __builtin_amdgcn_mfma_i32_16x16x64_i8(__builtin_bit_cast(i32x4, Bt[n][k]), __builtin_bit_cast(i32x4, At[m][k]), __builtin_bit_cast(i32x4, acc[ai][bj][m][n]), 0, 0, 0)); \
          else acc[ai][bj][m][n] = __builtin_amdgcn_mfma_f32_16x16x32_bf16(Bt[n][k], At[m][k], acc[ai][bj][m][n], 0, 0, 0); } __builtin_amdgcn_s_setprio(0); } while (0)
#define PG8_WAIT_V(n) asm volatile("s_waitcnt vmcnt(" #n ")" ::: "memory")
#define PG8_WAIT_L(n) asm volatile("s_waitcnt lgkmcnt(" #n ")" ::: "memory")
#define PG8_BAR __builtin_amdgcn_s_barrier()
#define PG8_SCHED __builtin_amdgcn_sched_barrier(0)
    Unit cur, nxt; int ui = 0;
    if (!S.next(0, cur)) return;
    f32x4 acc[2][2][4][2];
#pragma unroll
    for (int a = 0; a < 2; ++a)
#pragma unroll
        for (int b = 0; b < 2; ++b)
#pragma unroll
            for (int m = 0; m < 4; ++m)
#pragma unroll
                for (int n = 0; n < 2; ++n) acc[a][b][m][n] = (f32x4){0.f, 0.f, 0.f, 0.f};
    bf16x8 At[4][2], B0[2][2], B1[2][2];
    const char* cA = (const char*)g.A + (size_t)cur.pm * tstep; const char* cB = (const char*)g.Bt + (size_t)cur.pn * tstep;
    S.a_ready(cur);
    if constexpr (SP2) {
        PG8_STAGE(PG8_SB(0, 0), cB, voffB); PG8_STAGE(PG8_SB(0, 1), cB + hstep, voffB); PG8_STAGE(PG8_SA(0, 0), cA, voffA); PG8_STAGE(PG8_SA(0, 1), cA + hstep, voffA);
        if (wr == 1) PG8_BAR;
        PG8_WAIT_V(2); PG8_BAR;
        PG8_STAGE(PG8_SB(1, 0), cB + kstep, voffB); PG8_STAGE(PG8_SA(1, 0), cA + kstep, voffA); PG8_STAGE(PG8_SB(1, 1), cB + hstep + kstep, voffB);
        PG8_WAIT_V(6); PG8_BAR;
    } else {
        PG8_STAGE(PG8_SB(0, 0), cB, voffB); PG8_STAGE(PG8_SA(0, 0), cA, voffA); PG8_STAGE(PG8_SB(0, 1), cB + hstep, voffB); PG8_STAGE(PG8_SA(0, 1), cA + hstep, voffA);
        if (wr == 1) PG8_BAR;
        PG8_WAIT_V(4); PG8_BAR;
        PG8_STAGE(PG8_SB(1, 0), cB + kstep, voffB); PG8_STAGE(PG8_SA(1, 0), cA + kstep, voffA); PG8_STAGE(PG8_SB(1, 1), cB + hstep + kstep, voffB);
        PG8_WAIT_V(6); PG8_BAR;
    }
    for (;;) {
        const bool has_next = S.next(ui + 1, nxt);
        const char* nA = has_next ? (const char*)g.A + (size_t)nxt.pm * tstep : cA; const char* nB = has_next ? (const char*)g.Bt + (size_t)nxt.pn * tstep : cB;
        for (int t = 0; t < nt; t += 2) {
            if constexpr (Epi::MIDHOOK) { if (t == (nt >> 1)) E.mid(acc, cur, wr, wc, fr, fq); }
            const bool last = (t == nt - 2);
            const char* a1 = cA + (size_t)(t + 1) * kstep;
            const char* a2 = last ? nA : cA + (size_t)(t + 2) * kstep; const char* b2 = last ? nB : cB + (size_t)(t + 2) * kstep;
            const char* a3 = a2 + kstep; const char* b3 = b2 + kstep;
            if (last && has_next) S.a_ready(nxt);
            if constexpr (SP2) {
            PG8_LDB(B0, 0, 0); PG8_LDB(B1, 0, 1); PG8_SCHED; PG8_LDA(At, 0, 0); PG8_STAGE(PG8_SA(1, 1), a1 + hstep, voffA);
            PG8_WAIT_V(8); PG8_WAIT_L(0); PG8_BAR; PG8_MMA(0, 0, At, B0); PG8_MMA(0, 1, At, B1); PG8_BAR; PG8_SCHED;
            PG8_LDA(At, 0, 1); PG8_STAGE(PG8_SB(0, 0), b2, voffB); PG8_STAGE(PG8_SB(0, 1), b2 + hstep, voffB); PG8_STAGE(PG8_SA(0, 0), a2, voffA);
            PG8_WAIT_V(8); PG8_WAIT_L(0); PG8_BAR; PG8_MMA(1, 0, At, B0); PG8_MMA(1, 1, At, B1); PG8_BAR; PG8_SCHED;
            PG8_LDB(B0, 1, 0); PG8_LDB(B1, 1, 1); PG8_SCHED; PG8_LDA(At, 1, 0); PG8_STAGE(PG8_SA(0, 1), a2 + hstep, voffA);
            PG8_WAIT_V(8); PG8_WAIT_L(0); PG8_BAR; PG8_MMA(0, 0, At, B0); PG8_MMA(0, 1, At, B1); PG8_BAR; PG8_SCHED;
            PG8_LDA(At, 1, 1); PG8_STAGE(PG8_SB(1, 0), b3, voffB); PG8_STAGE(PG8_SB(1, 1), b3 + hstep, voffB); PG8_STAGE(PG8_SA(1, 0), a3, voffA);
            PG8_WAIT_V(8); PG8_WAIT_L(0); PG8_BAR; PG8_MMA(1, 0, At, B0); PG8_MMA(1, 1, At, B1); PG8_BAR; PG8_SCHED;
            } else {
            PG8_LDB(B0, 0, 0); PG8_SCHED; PG8_LDA(At, 0, 0); PG8_STAGE(PG8_SA(1, 1), a1 + hstep, voffA);
            PG8_WAIT_L(8); PG8_BAR; PG8_WAIT_L(0); PG8_MMA(0, 0, At, B0); PG8_BAR; PG8_SCHED;
            PG8_LDB(B1, 0, 1); PG8_STAGE(PG8_SB(0, 0), b2, voffB);
            PG8_BAR; PG8_WAIT_L(0); PG8_MMA(0, 1, At, B1); PG8_BAR;
            PG8_LDA(At, 0, 1); PG8_STAGE(PG8_SA(0, 0), a2, voffA);
            PG8_BAR; PG8_WAIT_L(0); PG8_MMA(1, 0, At, B0); PG8_BAR; PG8_SCHED;
            PG8_STAGE(PG8_SB(0, 1), b2 + hstep, voffB);
            PG8_WAIT_V(6); PG8_BAR; PG8_MMA(1, 1, At, B1); PG8_BAR;
            PG8_LDB(B0, 1, 0); PG8_SCHED; PG8_LDA(At, 1, 0); PG8_STAGE(PG8_SA(0, 1), a2 + hstep, voffA);
            PG8_WAIT_L(8); PG8_BAR; PG8_WAIT_L(0); PG8_MMA(0, 0, At, B0); PG8_BAR; PG8_SCHED;
            PG8_LDB(B1, 1, 1); PG8_STAGE(PG8_SB(1, 0), b3, voffB);
            PG8_BAR; PG8_WAIT_L(0); PG8_MMA(0, 1, At, B1); PG8_BAR;
            PG8_LDA(At, 1, 1); PG8_STAGE(PG8_SA(1, 0), a3, voffA);
            PG8_BAR; PG8_WAIT_L(0); PG8_MMA(1, 0, At, B0); PG8_BAR; PG8_SCHED;
            PG8_STAGE(PG8_SB(1, 1), b3 + hstep, voffB);
            PG8_WAIT_V(6); PG8_BAR; PG8_MMA(1, 1, At, B1); PG8_BAR;
            }
        }
        if constexpr (ALIGN_EPI) { if (wr == 0) PG8_BAR; }
        if constexpr (I8) {
#pragma unroll
            for (int a = 0; a < 2; ++a)
#pragma unroll
                for (int b = 0; b < 2; ++b)
#pragma unroll
                    for (int m = 0; m < 4; ++m)
#pragma unroll
                        for (int n = 0; n < 2; ++n)
#pragma unroll
                            for (int j = 0; j < 4; ++j) acc[a][b][m][n][j] = (float)__float_as_int(acc[a][b][m][n][j]);
        }
        if constexpr (!Epi::AFTER_DRAIN) { E(acc, cur, wr, wc, fr, fq); S.done(cur); }
        if (!has_next) break;
#pragma unroll
        for (int a = 0; a < 2; ++a)
#pragma unroll
            for (int b = 0; b < 2; ++b)
#pragma unroll
                for (int m = 0; m < 4; ++m)
#pragma unroll
                    for (int n = 0; n < 2; ++n) acc[a][b][m][n] = (f32x4){0.f, 0.f, 0.f, 0.f};
        cur = nxt; cA = nA; cB = nB; ++ui;
        if constexpr (ALIGN_EPI) { if (wr == 1) PG8_BAR; }
    }
    PG8_WAIT_V(0);
    if constexpr (!ALIGN_EPI) { if (wr == 0) PG8_BAR; }
    PG8_BAR;
    if constexpr (Epi::AFTER_DRAIN) { E.fused(acc, cur, wr, wc, fr, fq, lds, wid, lane); S.done(cur); }
#undef PG8_SA
#undef PG8_SB
#undef PG8_STAGE
#undef PG8_LDA
#undef PG8_LDB
#undef PG8_MMA
#undef PG8_WAIT_V
#undef PG8_WAIT_L
#undef PG8_BAR
#undef PG8_SCHED
}
}
namespace att {
typedef unsigned short u16;
typedef short bf16x8 __attribute__((ext_vector_type(8)));
typedef short s16x4 __attribute__((ext_vector_type(4)));
typedef float f32x16 __attribute__((ext_vector_type(16)));
typedef float f32x4 __attribute__((ext_vector_type(4)));
typedef unsigned u32x4 __attribute__((ext_vector_type(4)));
constexpr int D = 128, NW = 8, QBLK = 32, KVBLK = 64, QB = NW * QBLK;
constexpr int SHM_V = KVBLK * D * 2, SHM_K = KVBLK * D * 2;
constexpr int OFF_WS = 2 * SHM_V + 2 * SHM_K, OFF_KM = OFF_WS + NW * 64 * 4, ATT_LDS = OFF_KM + 8192;
constexpr float SCALE = 0.08838834764831845f, THR = 8.f;
#define KSWZ(row, colB) ((row) * 256 + ((colB) ^ (((row) & 7) << 4)))
#define SBAR() __builtin_amdgcn_sched_barrier(0)
__device__ __forceinline__ int v_st(int k, int c) { const int kk = (k & ~0xC) | ((k & 4) << 1) | ((k & 8) >> 1); return ((kk >> 3) * 4 + (c >> 5)) * 512 + ((kk & 7) * 32 + (c & 31)) * 2; }
__device__ __forceinline__ int v_rd_base(int lane) { return ((lane & 3) << 3) | (((lane >> 2) & 3) << 6) | (((lane >> 4) & 1) << 5) | (((lane >> 5) & 1) << 8); }
constexpr int v_rd_off(int d0, int ks, int half) { return d0 * 512 + ks * 4096 + half * 2048; }
__device__ __forceinline__ int crow(int r, int hi) { return (r & 3) + 8 * (r >> 2) + 4 * hi; }
__device__ __forceinline__ unsigned cvtpk(float lo, float hi) { unsigned r; asm volatile("v_cvt_pk_bf16_f32 %0, %1, %2" : "=v"(r) : "v"(lo), "v"(hi)); return r; }
__device__ __forceinline__ bf16x8 pack8(f32x4 a, f32x4 b) { u32x4 w = {cvtpk(a[0], a[1]), cvtpk(a[2], a[3]), cvtpk(b[0], b[1]), cvtpk(b[2], b[3])}; return *reinterpret_cast<bf16x8*>(&w); }
__device__ __forceinline__ bf16x8 load8(const u16* p) { return *reinterpret_cast<const bf16x8*>(p); }
__device__ __forceinline__ bf16x8 ldg8(const u16* ubase, unsigned voff) { return *reinterpret_cast<const bf16x8*>((const char*)ubase + voff); }
__device__ __forceinline__ void mask_tile(f32x16& p0, f32x16& p1, int dq) {
    const float NEG = -__builtin_inff();
#pragma unroll
    for (int r = 0; r < 16; ++r) { const int c = (r & 3) + 8 * (r >> 2); if (dq - c < 0) p0[r] = NEG; if (dq - c - 32 < 0) p1[r] = NEG; }
}
__device__ __forceinline__ void partialSM(f32x16& p0, f32x16& p1, float& m_reg, float& mn, float& alpha, bool off) {
    float pmax = p0[0];
#pragma unroll
    for (int r = 1; r < 16; ++r) pmax = fmaxf(pmax, p0[r]);
#pragma unroll
    for (int r = 0; r < 16; ++r) pmax = fmaxf(pmax, p1[r]);
    { auto rr = __builtin_amdgcn_permlane32_swap(__float_as_uint(pmax), __float_as_uint(pmax), false, false);
      pmax = fmaxf(__uint_as_float(rr[0]), __uint_as_float(rr[1])); }
    if (off) pmax = -__builtin_inff();
    constexpr float C2 = 1.4426950408889634f * SCALE;
    if (__builtin_expect(__all((pmax - m_reg) * SCALE <= THR), 1)) { mn = m_reg; alpha = 1.f; }
    else { mn = fmaxf(m_reg, pmax); alpha = __builtin_amdgcn_exp2f((m_reg - mn) * C2); m_reg = mn; }
    float mnL = -mn * C2; if (off) mnL = -__builtin_inff();
#pragma unroll
    for (int r = 0; r < 16; ++r) p0[r] = fmaf(p0[r], C2, mnL);
#pragma unroll
    for (int r = 0; r < 16; ++r) p1[r] = fmaf(p1[r], C2, mnL);
#pragma unroll
    for (int r = 0; r < 16; ++r) p0[r] = __builtin_amdgcn_exp2f(p0[r]);
}
__device__ __forceinline__ void finishSM(f32x16& p0, f32x16& p1, float alpha, float& l_reg, bf16x8& pa0, bf16x8& pa1, bf16x8& pa2, bf16x8& pa3) {
#pragma unroll
    for (int r = 0; r < 16; ++r) p1[r] = __builtin_amdgcn_exp2f(p1[r]);
    float ps = 0;
#pragma unroll
    for (int r = 0; r < 16; ++r) ps += p0[r];
#pragma unroll
    for (int r = 0; r < 16; ++r) ps += p1[r];
    { auto rr = __builtin_amdgcn_permlane32_swap(__float_as_uint(ps), __float_as_uint(ps), false, false);
      ps = __uint_as_float(rr[0]) + __uint_as_float(rr[1]); }
    l_reg = l_reg * alpha + ps;
#define PK4(P, B_, OUT) do { unsigned a0 = cvtpk(P[B_+0], P[B_+1]), a1 = cvtpk(P[B_+2], P[B_+3]);                          \
        unsigned b0 = cvtpk(P[B_+4], P[B_+5]), b1 = cvtpk(P[B_+6], P[B_+7]);                                             \
        auto r0 = __builtin_amdgcn_permlane32_swap(a0, b0, false, false); auto r1 = __builtin_amdgcn_permlane32_swap(a1, b1, false, false); \
        u32x4 w = {r0[0], r1[0], r0[1], r1[1]}; OUT = *reinterpret_cast<bf16x8*>(&w); } while (0)
    PK4(p0, 0, pa0); PK4(p0, 8, pa1); PK4(p1, 0, pa2); PK4(p1, 8, pa3);
#undef PK4
}
template <int KB>
__device__ __forceinline__ void qkt(f32x16& p0, f32x16& p1, const char* K_lds, int r32, int hi, const bf16x8* qr) {
    p0 = f32x16{}; p1 = f32x16{};
    const char* kb[4];
#pragma unroll
    for (int dd = 0; dd < 4; ++dd) kb[dd] = K_lds + KB * SHM_K + KSWZ(r32, (dd * 16 + hi * 8) * 2);
#pragma unroll
    for (int d0 = 0; d0 < 8; ++d0) { const char* a = kb[d0 & 3] + (d0 >> 2) * 128;
        bf16x8 b0 = *reinterpret_cast<const bf16x8*>(a);
        bf16x8 b1 = *reinterpret_cast<const bf16x8*>(a + 32 * 256);
        p0 = __builtin_amdgcn_mfma_f32_32x32x16_bf16(b0, qr[d0], p0, 0, 0, 0);
        p1 = __builtin_amdgcn_mfma_f32_32x32x16_bf16(b1, qr[d0], p1, 0, 0, 0); }
}
template <int VB>
__device__ __forceinline__ void pv_tile(f32x16* o, int vb0, bf16x8 pa0, bf16x8 pa1, bf16x8 pa2, bf16x8 pa3) {
#define TRRD(dst, off) asm volatile("ds_read_b64_tr_b16 %0, %1 offset:%2" : "=&v"(dst) : "v"(vb0), "i"(off) : "memory")
#define PV_D0(d0) do { s16x4 l0, l1, l2, l3, h0, h1, h2, h3; constexpr int b_ = VB * SHM_V + v_rd_off(d0, 0, 0); \
        TRRD(l0, b_); TRRD(h0, b_ + 2048); TRRD(l1, b_ + 4096); TRRD(h1, b_ + 6144); TRRD(l2, b_ + 8192); TRRD(h2, b_ + 10240); TRRD(l3, b_ + 12288); TRRD(h3, b_ + 14336); \
        asm volatile("s_waitcnt lgkmcnt(0)" ::: "memory"); SBAR();   \
        o[d0] = __builtin_amdgcn_mfma_f32_32x32x16_bf16(pa0, (bf16x8){l0[0], l0[1], l0[2], l0[3], h0[0], h0[1], h0[2], h0[3]}, o[d0], 0, 0, 0);   \
        o[d0] = __builtin_amdgcn_mfma_f32_32x32x16_bf16(pa1, (bf16x8){l1[0], l1[1], l1[2], l1[3], h1[0], h1[1], h1[2], h1[3]}, o[d0], 0, 0, 0);   \
        o[d0] = __builtin_amdgcn_mfma_f32_32x32x16_bf16(pa2, (bf16x8){l2[0], l2[1], l2[2], l2[3], h2[0], h2[1], h2[2], h2[3]}, o[d0], 0, 0, 0);   \
        o[d0] = __builtin_amdgcn_mfma_f32_32x32x16_bf16(pa3, (bf16x8){l3[0], l3[1], l3[2], l3[3], h3[0], h3[1], h3[2], h3[3]}, o[d0], 0, 0, 0); } while (0)
    PV_D0(0); PV_D0(1); PV_D0(2); PV_D0(3);
#undef PV_D0
#undef TRRD
}
struct BlockRef { const u16* Q; const u16* K; const u16* V; const u16* Z; u16* O; const float* KM; int qb; };
struct Seam { bf16x8 qr[8]; bf16x8 st_v0, st_v1, st_k0, st_k1; };
#define ROW(p, k0, rr) ((p) + (size_t)((k0) + (rr)) * LDP + sc)
#define VMW() asm volatile("s_waitcnt vmcnt(0)" ::: "memory")
#define VMWN(n) asm volatile("s_waitcnt vmcnt(%0)" :: "i"(n) : "memory")
#define SLOAD_H(Kp, Vp, k0) do { const u16* vt_ = (Vp) + (size_t)(k0) * LDP; const u16* kt_ = (Kp) + (size_t)(k0) * LDP;            \
                         S.st_v0 = ldg8(vt_, roff); S.st_v1 = ldg8(vt_ + 32 * LDP, roff); S.st_k0 = ldg8(kt_, roff); S.st_k1 = ldg8(kt_ + 32 * LDP, roff); } while (0)
#define SWRITE_HK(bf) do { *(bf16x8*)(K_lds + (bf) * SHM_K + kws) = S.st_k0; *(bf16x8*)(K_lds + (bf) * SHM_K + kws + 32 * 256) = S.st_k1; } while (0)
#define SWRITE_HV(bf) do { *(bf16x8*)(V_lds + (bf) * SHM_V + vst0) = S.st_v0; *(bf16x8*)(V_lds + (bf) * SHM_V + vst1) = S.st_v1; } while (0)
#define SWRITE_H(bf) do { SWRITE_HV(bf); SWRITE_HK(bf); } while (0)
__device__ __forceinline__ void moba_prime(const BlockRef& cur, char* lds, Seam& S) {
    const int tid = threadIdx.x, wid = __builtin_amdgcn_readfirstlane(tid >> 6), lane = tid & 63, r32 = lane & 31, hi = lane >> 5;
    const int sr = tid >> 4, sc = (tid & 15) * 8, kws = KSWZ(sr, sc * 2); char* K_lds = lds + 2 * SHM_V;
    const unsigned roff = (unsigned)(sr * LDP + sc) * 2u, qoff = (unsigned)((wid * QBLK + r32) * LDP + hi * 8) * 2u;
#pragma unroll
    for (int d0 = 0; d0 < 8; ++d0) S.qr[d0] = ldg8(cur.Q + d0 * 16, qoff);
    SLOAD_H(cur.K, cur.V, 0); VMW(); SWRITE_HK(0);
    __syncthreads();
}
__device__ __forceinline__ void moba_block(const BlockRef& cur, const BlockRef& nxt, char* lds, Seam& S) {
    int tid_ = threadIdx.x; asm volatile("" : "+v"(tid_));
    const int tid = tid_, wid = __builtin_amdgcn_readfirstlane(tid >> 6), lane = tid & 63, r32 = lane & 31, hi = lane >> 5;
    const int NT = 4 * (cur.qb + 1), P0 = cur.qb * QB;
    const int qlo = P0 + wid * QBLK, qm = qlo + r32 - 4 * hi;
    char* V_lds = lds; char* K_lds = lds + 2 * SHM_V;
    float* ws = (float*)(lds + OFF_WS) + wid * 64; float* li_l = ws, * al_l = ws + 32;
    float m_reg = -1e30f, l_reg = 0; f32x16 o[4] = {};
    const int sr = tid >> 4, sc = (tid & 15) * 8, vst0 = v_st(sr, sc), vst1 = v_st(32 + sr, sc), kws = KSWZ(sr, sc * 2);
    const int vb0 = (int)(uintptr_t)V_lds + v_rd_base(lane);
    const unsigned roff = (unsigned)(sr * LDP + sc) * 2u, qoff = (unsigned)((wid * QBLK + r32) * LDP + hi * 8) * 2u;
    const u16* Kh = cur.K; const u16* Vh = cur.V;
    unsigned sel = 0xffffu;
    if (cur.qb > 3) {
        char* KMT = lds + OFF_KM;
        { const int row = tid >> 4, c = tid & 15, j = row & 15;
          const float* kp = cur.KM + (size_t)j * 2048 + c * 8;
          const f32x4 a0 = *(const f32x4*)kp, a1 = *(const f32x4*)(kp + 4), b0 = *(const f32x4*)(kp + 128), b1 = *(const f32x4*)(kp + 132);
          const f32x4 x0 = (a0 + b0) * (1.0f / 256.0f), x1 = (a1 + b1) * (1.0f / 256.0f);
          const bf16x8 hv = pack8(x0, x1);
          f32x4 y0, y1;
#pragma unroll
          for (int i = 0; i < 4; ++i) { y0[i] = x0[i] - __uint_as_float(((unsigned)(unsigned short)hv[i]) << 16); y1[i] = x1[i] - __uint_as_float(((unsigned)(unsigned short)hv[4 + i]) << 16); }
          const bf16x8 lv = pack8(y0, y1);
          *(bf16x8*)(KMT + KSWZ(row, c * 16)) = (row >> 4) ? lv : hv; }
        __syncthreads();
        f32x16 g = f32x16{};
#pragma unroll
        for (int d0 = 0; d0 < 8; ++d0) { const bf16x8 a = *reinterpret_cast<const bf16x8*>(KMT + KSWZ(r32, (d0 * 16 + hi * 8) * 2));
            g = __builtin_amdgcn_mfma_f32_32x32x16_bf16(a, S.qr[d0], g, 0, 0, 0); }
        float G[16];
#pragma unroll
        for (int r = 0; r < 8; ++r) { const float gv = g[r] + g[r + 8];
            auto rr = __builtin_amdgcn_permlane32_swap(__float_as_uint(gv), __float_as_uint(gv), false, false);
            G[(r & 3) + 8 * (r >> 2)] = __uint_as_float(rr[0]); G[(r & 3) + 8 * (r >> 2) + 4] = __uint_as_float(rr[1]); }
        sel = 1u << cur.qb;
#pragma unroll
        for (int k = 0; k < 3; ++k) { float best = -__builtin_inff(); int bi = 0;
#pragma unroll
            for (int j = 0; j < 16; ++j) { const float v = (j < cur.qb && !((sel >> j) & 1u)) ? G[j] : -__builtin_inff(); if (v > best) { best = v; bi = j; } }
            sel |= 1u << bi; }
    }
#define OFF(t) (!((sel >> ((t) >> 2)) & 1u))
#define RESC(a) do { if (__any((a) < 1.f)) { if (hi == 0) al_l[r32] = (a); asm volatile("s_waitcnt lgkmcnt(0)" ::: "memory");              \
                     for (int d_ = 0; d_ < 4; ++d_) for (int r = 0; r < 16; ++r) o[d_][r] *= al_l[crow(r, hi)]; } } while (0)
#define KBASE(t) ((t) * KVBLK)
#define MASKT(P0_, P1_, t) do { const int kb_ = KBASE(t); if (kb_ + KVBLK - 1 > qlo) mask_tile(P0_, P1_, qm - kb_); } while (0)
#define SEAM_K0() do { VMWN(8); SWRITE_HK(0); SBAR(); } while (0)
    f32x16 pA0, pA1, pB0, pB1; float mnA, mnB, alA, alB; bf16x8 pa0, pa1, pa2, pa3;
    SWRITE_HV(0); SBAR();
    if (NT > 1) SLOAD_H(Kh, Vh, KBASE(1));
    SBAR(); qkt<0>(pA0, pA1, K_lds, r32, hi, S.qr);
    MASKT(pA0, pA1, 0); partialSM(pA0, pA1, m_reg, mnA, alA, OFF(0));
    if (NT > 1) { VMW(); SWRITE_H(1); }
    __syncthreads();
#define HALF_STEP(PX0, PX1, mnX, alX, PY0, PY1, alY, t, KB, VB, SB) do {                                                      \
        SBAR(); qkt<KB>(PX0, PX1, K_lds, r32, hi, S.qr);                                                                      \
        finishSM(PY0, PY1, alY, l_reg, pa0, pa1, pa2, pa3); SBAR();                                                           \
        if ((t) + 1 < NT) { SLOAD_H(Kh, Vh, KBASE((t) + 1)); SBAR(); }                                                        \
        pv_tile<VB>(o, vb0, pa0, pa1, pa2, pa3); MASKT(PX0, PX1, (t)); partialSM(PX0, PX1, m_reg, mnX, alX, OFF(t));           \
        __syncthreads();                                                                                                      \
        if ((t) + 1 < NT) { VMW(); SWRITE_H(SB); }                                                                            \
        RESC(alX); __syncthreads(); } while (0)
    for (int t = 1; t + 1 < NT; t += 2) {
        HALF_STEP(pB0, pB1, mnB, alB, pA0, pA1, alA, t, 1, 0, 0);
        HALF_STEP(pA0, pA1, mnA, alA, pB0, pB1, alB, t + 1, 0, 1, 1);
    }
    const bool even = (NT & 1) == 0;
    if (even) { SBAR(); qkt<1>(pB0, pB1, K_lds, r32, hi, S.qr); SBAR(); }
    SLOAD_H(nxt.K, nxt.V, 0); SBAR();
#pragma unroll
    for (int d0 = 0; d0 < 8; ++d0) S.qr[d0] = ldg8(nxt.Q + d0 * 16, qoff);
    SBAR();
    finishSM(pA0, pA1, alA, l_reg, pa0, pa1, pa2, pa3); SBAR();
    pv_tile<0>(o, vb0, pa0, pa1, pa2, pa3);
    if (even) { MASKT(pB0, pB1, NT - 1); partialSM(pB0, pB1, m_reg, mnB, alB, OFF(NT - 1)); __syncthreads(); RESC(alB);
        finishSM(pB0, pB1, alB, l_reg, pa0, pa1, pa2, pa3); SBAR(); pv_tile<1>(o, vb0, pa0, pa1, pa2, pa3); }
    SBAR(); SEAM_K0();
    if (hi == 0) li_l[r32] = l_reg; asm volatile("s_waitcnt lgkmcnt(0)" ::: "memory");
    float rli[16];
#pragma unroll
    for (int r = 0; r < 16; ++r) rli[r] = __builtin_amdgcn_rcpf(li_l[crow(r, hi)]);
    __syncthreads();
    char* stg = V_lds + wid * 4096;
    const int srow = lane >> 4, schunk = lane & 15;
#pragma unroll
    for (int h = 0; h < 2; ++h) {
        u32x4 zq[4];
#pragma unroll
        for (int k = 0; k < 4; ++k) zq[k] = *(const u32x4*)(cur.Z + (size_t)(wid * QBLK + 16 * h + 4 * k + srow) * LDP + schunk * 8);
#pragma unroll
        for (int rr = 0; rr < 8; ++rr) { const int r = 8 * h + rr, row = (rr & 3) + 8 * (rr >> 2) + 4 * hi;
#pragma unroll
            for (int d0 = 0; d0 < 4; ++d0) { const float v = o[d0][r] * rli[r];
                *(unsigned short*)(stg + (row * 128 + d0 * 32 + r32) * 2) = (unsigned short)(cvtpk(v, v) & 0xffffu); } }
        asm volatile("s_waitcnt lgkmcnt(0)" ::: "memory");
#pragma unroll
        for (int k = 0; k < 4; ++k) { const u32x4 ov = *(const u32x4*)(stg + ((4 * k + srow) * 128 + schunk * 8) * 2); const u32x4 z = zq[k]; u32x4 w;
#define MZ(a, b) cvtpk(__uint_as_float((a) << 16) * __uint_as_float((b) << 16), __uint_as_float((a) & 0xffff0000u) * __uint_as_float((b) & 0xffff0000u))
            w.x = MZ(ov.x, z.x); w.y = MZ(ov.y, z.y); w.z = MZ(ov.z, z.z); w.w = MZ(ov.w, z.w);
#undef MZ
            *(u32x4*)(cur.O + (size_t)(wid * QBLK + 16 * h + 4 * k + srow) * DM + schunk * 8) = w; }
        asm volatile("s_waitcnt lgkmcnt(0)" ::: "memory");
    }
    __syncthreads();
#undef OFF
#undef RESC
#undef KBASE
#undef MASKT
#undef SEAM_K0
#undef HALF_STEP
}
#undef ROW
#undef VMW
#undef VMWN
#undef SLOAD_H
#undef SWRITE_HK
#undef SWRITE_HV
#undef SWRITE_H
}

#define LAS __attribute__((address_space(3)))
typedef unsigned short u16;
typedef float f32x4_t __attribute__((ext_vector_type(4)));
typedef unsigned u32x4_t __attribute__((ext_vector_type(4)));
typedef unsigned u32x2_t __attribute__((ext_vector_type(2)));
typedef short bf16x8_t __attribute__((ext_vector_type(8)));
__device__ __forceinline__ unsigned pk2(float lo, float hi) { return pg8::cvt_pk_bf16(lo, hi); }
__device__ __forceinline__ float wave_sum(float v) {
#pragma unroll
    for (int o = 1; o < 64; o <<= 1) v += __shfl_xor(v, o);
    return v;
}
__device__ __forceinline__ void transpose_item(const float* W, int N, u16* WT, int ldo, int col_off, LAS float* scr, int item, int lane) {
    const int nblk = N / 64, kb = item / nblk, nb = item % nblk, k0 = 64 * kb, n0 = 64 * nb;
    const float* src = W + (size_t)(k0 + (lane >> 4)) * N + n0 + (lane & 15) * 4;
    f32x4_t v[16];
#pragma unroll
    for (int i = 0; i < 16; ++i) v[i] = *(const f32x4_t*)(src + (size_t)(4 * i) * N);
#pragma unroll
    for (int i = 0; i < 16; ++i) *(LAS f32x4_t*)(scr + (4 * i + (lane >> 4)) * 68 + (((lane & 15) * 4 + 4 * (i >> 1)) & 63)) = v[i];
    asm volatile("s_waitcnt lgkmcnt(0)" ::: "memory");
    const int c = lane & 7;
#pragma unroll
    for (int j = 0; j < 8; ++j) { const int n = (lane >> 3) + 8 * j; const LAS float* s = scr + (8 * c) * 68 + ((n + 4 * c) & 63);
        u32x4_t o; o.x = pk2(s[0 * 68], s[1 * 68]); o.y = pk2(s[2 * 68], s[3 * 68]); o.z = pk2(s[4 * 68], s[5 * 68]); o.w = pk2(s[6 * 68], s[7 * 68]);
        *(u32x4_t*)(WT + (size_t)(n0 + n) * ldo + col_off + k0 + 8 * c) = o; }
    asm volatile("s_waitcnt lgkmcnt(0)" ::: "memory");
}
struct Params {
    const float *x, *norm_g, *w_in, *q_g, *k_g, *sgu_g, *w_s, *b_s, *w_a, *w_b, *w_out;
    float* out; unsigned char* ws; int ph_lo, ph_hi;
};
__device__ __forceinline__ unsigned pack_i8x4(float a, float b, float c, float d) {
    const int ia = __float2int_rn(a), ib = __float2int_rn(b), ic = __float2int_rn(c), id = __float2int_rn(d);
    return (unsigned)(ia & 0xff) | ((unsigned)(ib & 0xff) << 8) | ((unsigned)(ic & 0xff) << 16) | ((unsigned)(id & 0xff) << 24);
}
__device__ __forceinline__ void i8_strip(const Params& p, LAS unsigned char* lds, int strip) {
    const int tid = threadIdx.x, lane = tid & 63, wave = __builtin_amdgcn_readfirstlane(tid >> 6), n = lane & 31, kg = lane >> 5;
    const int c8 = strip * 32, gl = c8 - 5120, wcol = (c8 < 4096 ? c8 : (c8 < 5120 ? c8 + 1024   : ((gl & 128) ? C_GB : C_GA) + 128 * (gl >> 8) + (gl & 127)));
    signed char* W8 = (signed char*)(p.ws + WS_W8); float* WSC = (float*)(p.ws + WS_WSC);
    LAS float* mx = (LAS float*)lds;
    const float* src = p.w_in + (size_t)(256 * wave + kg * 16) * LDP + wcol + n;
    float v[8][16]; float m = 0.f;
#pragma unroll
    for (int c = 0; c < 8; ++c)
#pragma unroll
        for (int i = 0; i < 16; ++i) v[c][i] = src[(size_t)(32 * c + i) * LDP];
#pragma unroll
    for (int c = 0; c < 8; ++c)
#pragma unroll
        for (int i = 0; i < 16; ++i) m = fmaxf(m, fabsf(v[c][i]));
    m = fmaxf(m, __shfl_xor(m, 32));
    if (lane < 32) mx[wave * 32 + lane] = m;
    __syncthreads();
    float cm = mx[n];
#pragma unroll
    for (int w = 1; w < 8; ++w) cm = fmaxf(cm, mx[w * 32 + n]);
    cm = fmaxf(cm, 1e-30f);
    const float inv = 127.0f / cm;
    if (wave == 0 && lane < 32) WSC[c8 + lane] = cm * (1.0f / 127.0f);
    signed char* dst = W8 + (size_t)(c8 + n) * DM + 256 * wave + kg * 16;
#pragma unroll
    for (int c = 0; c < 8; ++c) {
        u32x4_t o; o.x = pack_i8x4(v[c][0] * inv, v[c][1] * inv, v[c][2] * inv, v[c][3] * inv); o.y = pack_i8x4(v[c][4] * inv, v[c][5] * inv, v[c][6] * inv, v[c][7] * inv);
        o.z = pack_i8x4(v[c][8] * inv, v[c][9] * inv, v[c][10] * inv, v[c][11] * inv); o.w = pack_i8x4(v[c][12] * inv, v[c][13] * inv, v[c][14] * inv, v[c][15] * inv);
        *(u32x4_t*)(dst + 32 * c) = o; }
    __syncthreads();
}
__device__ __forceinline__ void phase_prep(const Params& p, LAS unsigned char* lds, int G) {
    const int tid = threadIdx.x, lane = tid & 63, wave = __builtin_amdgcn_readfirstlane(tid >> 6);
    for (int st = blockIdx.x; st < NI8_TILES * 8; st += G) i8_strip(p, lds, st);
    LAS float* scr = (LAS float*)(lds + wave * 17408);
    const int gw = blockIdx.x * 8 + wave, NGW = G * 8;
    u16* Bt1 = (u16*)(p.ws + WS_BT1); u16* Bt3 = (u16*)(p.ws + WS_BT3); u16* Bt4 = (u16*)(p.ws + WS_BT4);
    constexpr int NBFC = NBF_TILES * 256, I_IN = (DM / 64) * (NBFC / 64), I_A = (1024 / 64) * (DM / 64), I_O = (DM / 64) * (DM / 64), NITEMS = I_IN + 2 * I_A + I_O;
    for (int it = NGW - 1 - gw; it < NITEMS; it += NGW) {
        int r = it;
        if (r < I_IN) { const int kb = r / (NBFC / 64), nb = r % (NBFC / 64);
            transpose_item(p.w_in + 4096 + (nb >= 16 ? 1024 : 0), LDP, Bt1, DM, 0, scr, kb * (LDP / 64) + nb, lane); continue; } r -= I_IN;
        if (r < I_A) { transpose_item(p.w_a, DM, Bt3, DM, 0, scr, r, lane); continue; } r -= I_A;
        if (r < I_A) { transpose_item(p.w_b, DM, Bt3, DM, 1024, scr, r, lane); continue; } r -= I_A;
        transpose_item(p.w_out, DM, Bt4, DM, 0, scr, r, lane);
    }
    u16* H = (u16*)p.out;
    unsigned* H8 = (unsigned*)(p.ws + WS_H8); float* HSC = (float*)(p.ws + WS_HSC);
    const f32x4_t* gr = (const f32x4_t*)p.norm_g + lane;
    f32x4_t nx[8];
    if (gw < TOK) { const f32x4_t* xr = (const f32x4_t*)(p.x + (size_t)gw * DM) + lane;
#pragma unroll
        for (int j = 0; j < 8; ++j) nx[j] = xr[64 * j]; }
    for (int m = gw; m < TOK; m += NGW) {
        f32x4_t v[8]; float s0 = 0.f;
#pragma unroll
        for (int j = 0; j < 8; ++j) v[j] = nx[j];
        if (m + NGW < TOK) { const f32x4_t* xr = (const f32x4_t*)(p.x + (size_t)(m + NGW) * DM) + lane;
#pragma unroll
            for (int j = 0; j < 8; ++j) nx[j] = xr[64 * j]; }
#pragma unroll
        for (int j = 0; j < 8; ++j) s0 += (v[j].x * v[j].x + v[j].y * v[j].y) + (v[j].z * v[j].z + v[j].w * v[j].w);
        const float r0 = __builtin_amdgcn_rsqf(wave_sum(s0) * (1.0f / DM) + EPS);
        float mxv = 0.f;
#pragma unroll
        for (int j = 0; j < 8; ++j) { const f32x4_t g = gr[64 * j]; v[j] = v[j] * r0 * g; mxv = fmaxf(fmaxf(mxv, fmaxf(fabsf(v[j].x), fabsf(v[j].y))), fmaxf(fabsf(v[j].z), fabsf(v[j].w))); }
#pragma unroll
        for (int o = 1; o < 64; o <<= 1) mxv = fmaxf(mxv, __shfl_xor(mxv, o));
        mxv = fmaxf(mxv, 1e-30f); const float inv = 127.0f / mxv;
        if (lane == 0) HSC[m] = mxv * (1.0f / 127.0f);
        u32x2_t* o8 = (u32x2_t*)(H + (size_t)m * DM) + lane; unsigned* q8 = H8 + (size_t)m * (DM / 4) + lane;
#pragma unroll
        for (int j = 0; j < 8; ++j) { u32x2_t w; w.x = pk2(v[j].x, v[j].y); w.y = pk2(v[j].z, v[j].w); o8[64 * j] = w;
            q8[64 * j] = pack_i8x4(v[j].x * inv, v[j].y * inv, v[j].z * inv, v[j].w * inv); }
    }
}
struct SguRegs { u32x4_t vw[4]; f32x4_t w0[4], w1[4]; u32x2_t uu[8], zz[8]; float bias; };
__device__ __forceinline__ void sgu_load(const Params& p, int item, SguRegs& R) {
    const int tid = threadIdx.x, lane = tid & 63, wid = __builtin_amdgcn_readfirstlane(tid >> 6), fr = lane & 15, fq = lane >> 4;
    const int g = item & 7; const size_t tok0 = (size_t)(item >> 3) * 128; const int t = 16 * wid + fr;
    const u16* P = (const u16*)(p.ws + WS_PROJ);
#pragma unroll
    for (int ps = 0; ps < 4; ++ps) { const int s = (tid >> 6) * 16 + ((tid & 63) >> 2), cc = 4 * ps + (tid & 3);     R.vw[ps] = *(const u32x4_t*)(P + (tok0 + s) * LDP + C_VB + g * 128 + cc * 8); }
    const float* Wr = p.w_s + ((size_t)g * 128 + t) * 128 + 8 * fq;
#pragma unroll
    for (int ks = 0; ks < 4; ++ks) { if (32 * ks <= 16 * wid + 15) { R.w0[ks] = *(const f32x4_t*)(Wr + 32 * ks); R.w1[ks] = *(const f32x4_t*)(Wr + 32 * ks + 4); } else { R.w0[ks] = (f32x4_t){0.f, 0.f, 0.f, 0.f}; R.w1[ks] = R.w0[ks]; } }
    const u16* up = P + (tok0 + t) * LDP + C_UB + g * 128 + 8 * fq; const u16* zp = P + (tok0 + t) * LDP + C_ZB + g * 128 + 8 * fq;
#pragma unroll
    for (int cp = 0; cp < 4; ++cp) { const u32x4_t a = *(const u32x4_t*)(up + 32 * cp), b = *(const u32x4_t*)(zp + 32 * cp);
        R.uu[2 * cp] = (u32x2_t){a.x, a.y}; R.uu[2 * cp + 1] = (u32x2_t){a.z, a.w}; R.zz[2 * cp] = (u32x2_t){b.x, b.y}; R.zz[2 * cp + 1] = (u32x2_t){b.z, b.w}; }
    R.bias = p.b_s[g * 128 + t];
}
__device__ __forceinline__ void sgu_stage(LAS u16* vgT, const SguRegs& R) {
    const int tid = threadIdx.x;
#pragma unroll
    for (int ps = 0; ps < 4; ++ps) { const int s = (tid >> 6) * 16 + ((tid & 63) >> 2), cc = 4 * ps + (tid & 3);     const u32x4_t w = R.vw[ps];
        LAS u16* d = vgT + (cc * 8) * 136 + s;
        d[0 * 136] = (u16)(w.x & 0xffffu); d[1 * 136] = (u16)(w.x >> 16); d[2 * 136] = (u16)(w.y & 0xffffu); d[3 * 136] = (u16)(w.y >> 16);
        d[4 * 136] = (u16)(w.z & 0xffffu); d[5 * 136] = (u16)(w.z >> 16); d[6 * 136] = (u16)(w.w & 0xffffu); d[7 * 136] = (u16)(w.w >> 16); }
}
__device__ __forceinline__ void sgu_compute(const Params& p, const LAS u16* vgT, int item, const SguRegs& R) {
    const int tid = threadIdx.x, lane = tid & 63, wid = __builtin_amdgcn_readfirstlane(tid >> 6), fr = lane & 15, fq = lane >> 4;
    const int g = item & 7; const size_t tok0 = (size_t)(item >> 3) * 128; const int t = 16 * wid + fr;
    u16* AB = (u16*)p.out;
    f32x4_t acc[8];
#pragma unroll
    for (int ct = 0; ct < 8; ++ct) acc[ct] = (f32x4_t){0.f, 0.f, 0.f, 0.f};
#pragma unroll
    for (int ks = 0; ks < 4; ++ks) {
        if (32 * ks <= 16 * wid + 15) {
            const int s0 = 32 * ks + 8 * fq; f32x4_t a0 = R.w0[ks], a1 = R.w1[ks];
#pragma unroll
            for (int i = 0; i < 4; ++i) { if (s0 + i > t) a0[i] = 0.f; if (s0 + 4 + i > t) a1[i] = 0.f; }
            u32x4_t aw; aw.x = pk2(a0[0], a0[1]); aw.y = pk2(a0[2], a0[3]); aw.z = pk2(a1[0], a1[1]); aw.w = pk2(a1[2], a1[3]);
            const bf16x8_t a = *reinterpret_cast<bf16x8_t*>(&aw);
#pragma unroll
            for (int ct = 0; ct < 8; ++ct) { const bf16x8_t b = *(const LAS bf16x8_t*)(vgT + (32 * (ct >> 1) + 8 * (fr >> 2) + 4 * (ct & 1) + (fr & 3)) * 136 + s0);
                acc[ct] = __builtin_amdgcn_mfma_f32_16x16x32_bf16(b, a, acc[ct], 0, 0, 0); }
        }
    }
    u16* op = AB + (tok0 + t) * DM + 1024 + g * 128 + 8 * fq;
#pragma unroll
    for (int cp = 0; cp < 4; ++cp) { u32x4_t w4;
#pragma unroll
        for (int h = 0; h < 2; ++h) { const int ct = 2 * cp + h; const f32x4_t m = acc[ct] + R.bias;
            const unsigned lo = pk2(m[0] * pg8::bf_lo(R.uu[ct].x) * pg8::bf_lo(R.zz[ct].x), m[1] * pg8::bf_hi(R.uu[ct].x) * pg8::bf_hi(R.zz[ct].x));
            const unsigned hi = pk2(m[2] * pg8::bf_lo(R.uu[ct].y) * pg8::bf_lo(R.zz[ct].y), m[3] * pg8::bf_hi(R.uu[ct].y) * pg8::bf_hi(R.zz[ct].y));
            if (h == 0) { w4.x = lo; w4.y = hi; } else { w4.z = lo; w4.w = hi; } }
        *(u32x4_t*)(op + 32 * cp) = w4; }
}
__device__ __forceinline__ void sgu_phase(const Params& p, LAS unsigned char* lds, int first, int step, int nitems) {
    int it = first; if (it >= nitems) return;
    SguRegs A; sgu_load(p, it & 1023, A); int par = 0;
    for (;;) {
        LAS u16* vgT = (LAS u16*)(lds + par * 36864);
        sgu_stage(vgT, A);
        const int nx = it + step; const bool has = nx < nitems;
        SguRegs B; if (has) sgu_load(p, nx & 1023, B);
        __syncthreads();
        sgu_compute(p, vgT, it & 1023, A);
        if (!has) break;
        A = B; it = nx; par ^= 1;
    }
    __syncthreads();
}

#define XB_TMO      128
#define XB_XCNT(j)  (256  + 64 * (j))
#define XB_XSUB(j)  (1280 + 64 * (j))
#define XB_XGEN(j)  (2304 + 64 * (j))
#define XB_TOP      3328
#define XB_TOPGEN   3392
#define XCD_BAR_WORDS 3456
#define XB_SPIN_CAP (1u << 18)

__device__ __forceinline__ unsigned xb_ld(unsigned* p)              { return __hip_atomic_load(p, __ATOMIC_RELAXED, __HIP_MEMORY_SCOPE_AGENT); }
__device__ __forceinline__ unsigned xb_add(unsigned* p, unsigned v) { return __hip_atomic_fetch_add(p, v, __ATOMIC_RELAXED, __HIP_MEMORY_SCOPE_AGENT); }
__device__ __forceinline__ unsigned xb_xcc_id() { return (unsigned)__builtin_amdgcn_s_getreg((3 << 11) | 20) & 0xFu; }
#define XB_SPIN(cond, bar) do { unsigned _sp = 0; while (cond) { __builtin_amdgcn_s_sleep(1); \
    if ((++_sp & 255u) == 0u) { if (xb_ld(&(bar)[XB_TMO])) break; if (_sp > XB_SPIN_CAP) { atomicAdd(&(bar)[XB_TMO], 1u); break; } } } } while (0)

struct XcdBarrier {
    unsigned* bar; unsigned x;
    volatile LAS unsigned* st;
};

__device__ __forceinline__ XcdBarrier xcd_barrier_post(unsigned* bar, volatile LAS unsigned* st) {
    XcdBarrier b; b.bar = bar; b.x = xb_xcc_id(); b.st = st;
    if (threadIdx.x == 0) (void)xb_add(&bar[XB_XCNT(b.x)], 1u);
    return b;
}
__device__ __forceinline__ void xcd_barrier_complete(unsigned* bar, unsigned x, unsigned& nloc, unsigned& nx) {
    const unsigned G = gridDim.x * gridDim.y * gridDim.z;
    unsigned sum, cnt, mine, sp = 0u;
    for (;;) {
        sum = 0u; cnt = 0u; mine = 0u;
#pragma unroll
        for (unsigned j = 0; j < 16; ++j) { const unsigned c = xb_ld(&bar[XB_XCNT(j)]); sum += c; cnt += (c > 0u) ? 1u : 0u; mine = (j == x) ? c : mine; }
        if (sum == G) break;
        __builtin_amdgcn_s_sleep(1);
        if ((++sp & 255u) == 0u) { if (xb_ld(&bar[XB_TMO])) break; if (sp > XB_SPIN_CAP) { atomicAdd(&bar[XB_TMO], 1u); break; } }
    }
    nloc = mine > 0u ? mine : 1u; nx = cnt > 0u ? cnt : 1u;
}

__device__ __forceinline__ void xcd_barrier(const XcdBarrier& b) {
    asm volatile("s_waitcnt vmcnt(0)" ::: "memory");
    __syncthreads();
    if (threadIdx.x == 0) {
        unsigned* bar = b.bar;
        __builtin_amdgcn_s_waitcnt(0);
        unsigned nloc = b.st[0], nx = b.st[1];
        if (nloc == 0u) { xcd_barrier_complete(bar, b.x, nloc, nx); b.st[0] = nloc; b.st[1] = nx; }
        const unsigned old = xb_add(&bar[XB_XSUB(b.x)], 1u);
        const unsigned gen = old / nloc;
        if (old + 1u == (gen + 1u) * nloc) {
            __builtin_amdgcn_fence(__ATOMIC_RELEASE, "agent");
            asm volatile("s_waitcnt vmcnt(0)" ::: "memory");
            const unsigned og = xb_add(&bar[XB_TOP], 1u);
            const unsigned tg = og / nx;
            if (og + 1u == (tg + 1u) * nx) xb_add(&bar[XB_TOPGEN], 1u);
            else XB_SPIN(xb_ld(&bar[XB_TOPGEN]) == tg, bar);
            __builtin_amdgcn_fence(__ATOMIC_ACQUIRE, "agent");
            xb_add(&bar[XB_XGEN(b.x)], 1u);
            asm volatile("s_waitcnt vmcnt(0)" ::: "memory");
        } else {
            XB_SPIN(xb_ld(&bar[XB_XGEN(b.x)]) == gen, bar);
            __builtin_amdgcn_fence(__ATOMIC_ACQUIRE, "agent");
            asm volatile("s_waitcnt vmcnt(0)" ::: "memory");
        }
    }
    __syncthreads();
}


#define REP_P0 1
#define REP_P1 1
#define REP_ATT 1
#define REP_SGU 1
#define REP_P3 1
#define REP_P4 1
#ifndef SKIP_P0
#define SKIP_P0 0
#endif
#ifndef SKIP_P1
#define SKIP_P1 0
#endif
#ifndef SKIP_P2
#define SKIP_P2 0
#endif
#ifndef SKIP_P3
#define SKIP_P3 0
#endif
#ifndef SKIP_P4
#define SKIP_P4 0
#endif
__global__ void __launch_bounds__(512, 2) hybrid_fwd(Params p) {
    extern __shared__ __attribute__((aligned(16))) unsigned char lds_raw[];
    LAS unsigned char* lds = (LAS unsigned char*)lds_raw;
    cg::grid_group grid = cg::this_grid();
    const int G = gridDim.x, lo = p.ph_lo, hi = p.ph_hi;
    const u16* Bt1 = (const u16*)(p.ws + WS_BT1); const u16* Bt3 = (const u16*)(p.ws + WS_BT3); const u16* Bt4 = (const u16*)(p.ws + WS_BT4);
    u16* PROJ = (u16*)(p.ws + WS_PROJ); u16* MRG = (u16*)(p.ws + WS_MRG); float* KMP = (float*)(p.ws + WS_KMP); u16* HAB = (u16*)p.out;
#define IN(k) (lo <= (k) && (k) < hi)
#define SEAM(k) do { if (IN(k) && IN((k) + 1)) xcd_barrier(bar); } while (0)
    if (threadIdx.x < 4) ((LAS unsigned*)(lds + LDS_MISC))[threadIdx.x] = 0u;
    __syncthreads();
    XcdBarrier bar; bar.bar = (unsigned*)(p.ws + WS_BAR); bar.x = 0; bar.st = nullptr;
    if (hi - lo > 1) bar = xcd_barrier_post((unsigned*)(p.ws + WS_BAR), (volatile LAS unsigned*)(lds + LDS_MISC));
    if (hi > 99) grid.sync();
    if (IN(0) && !SKIP_P0) {
#pragma unroll 1
        for (int rep = 0; rep < REP_P0; ++rep) { phase_prep(p, lds, G); __syncthreads(); } }
    SEAM(0);
    if (IN(1) && !SKIP_P1) {
        const float* HSC = (const float*)(p.ws + WS_HSC); const float* WSC = (const float*)(p.ws + WS_WSC);
        {
            pg8::Gemm g{(const u16*)(p.ws + WS_H8), (const u16*)(p.ws + WS_W8), TOK, NI8_TILES * 256, DM / 2}; pg8::StaticOrder S; S.init(TOK, NI8_TILES * 256, G, (int)blockIdx.x, REP_P1, 5);
            pg8::EpiProj<true> E{PROJ, p.q_g, p.k_g, p.sgu_g, KMP, (LAS float*)(lds + LDS_XCH), HSC, WSC};
            pg8::gemm_phase<pg8::EpiProj<true>, pg8::StaticOrder, true, true, true>(lds, g, S, E);
        }
        {
            pg8::Gemm g{HAB, Bt1, TOK, NBF_TILES * 256, DM}; pg8::StaticOrder S; S.init(TOK, NBF_TILES * 256, G, (int)blockIdx.x, REP_P1, 5);
            pg8::EpiProj<false> E{PROJ, p.q_g, p.k_g, p.sgu_g, KMP, (LAS float*)(lds + LDS_XCH), HSC, WSC};
            pg8::gemm_phase<pg8::EpiProj<false>, pg8::StaticOrder, true, true, false>(lds, g, S, E);
        }
    }
    SEAM(1);
    if (IN(2) && !SKIP_P2) {
#ifndef SKIP_SGU
        sgu_phase(p, lds, (int)blockIdx.x, G, NB * 32 * 8 * REP_SGU);
#endif
#ifndef SKIP_ATT
        for (int L0 = blockIdx.x; L0 < 256 * REP_ATT; L0 += G) { const int Lr = L0 & 255, L = ((Lr & 7) << 5) | (Lr >> 3);
            const int bh = L >> 3, xx = L & 7, b = bh >> 3, h = bh & 7;
            att::BlockRef r0, r1;
            const u16* Pb = PROJ + (size_t)b * SEQ * LDP + h * HD;
            r0.K = r1.K = Pb + C_K; r0.V = r1.V = Pb + C_V; r0.KM = r1.KM = KMP + ((size_t)(b * 16) * 8 + h) * 256;
            r0.qb = xx; r1.qb = 15 - xx;
            r0.Q = Pb + (size_t)r0.qb * 256 * LDP + C_Q; r0.Z = Pb + (size_t)r0.qb * 256 * LDP + C_ZA; r0.O = HAB + ((size_t)b * SEQ + r0.qb * 256) * DM + h * HD;
            r1.Q = Pb + (size_t)r1.qb * 256 * LDP + C_Q; r1.Z = Pb + (size_t)r1.qb * 256 * LDP + C_ZA; r1.O = HAB + ((size_t)b * SEQ + r1.qb * 256) * DM + h * HD;
            att::Seam S;
            att::moba_prime(r0, (char*)lds_raw, S);
            att::BlockRef cur = r0;
#pragma unroll 1
            for (int pass = 0; pass < 2; ++pass) { att::moba_block(cur, r1, (char*)lds_raw, S); cur = r1; }
            asm volatile("s_waitcnt vmcnt(0)" ::: "memory"); __syncthreads();
        }
#endif
    }
    SEAM(2);
    if (IN(3) && !SKIP_P3) {
        pg8::Gemm g{HAB, Bt3, TOK, DM, DM}; pg8::StaticOrder S; S.init(TOK, DM, G, (int)blockIdx.x, REP_P3, 5);
        pg8::EpiMerge E{PROJ, MRG};
        pg8::gemm_phase<pg8::EpiMerge, pg8::StaticOrder, true, true>(lds, g, S, E);
    }
    SEAM(3);
    if (IN(4) && !SKIP_P4) {
        pg8::Gemm g{MRG, Bt4, TOK, DM, DM}; pg8::StaticOrder S; S.init(TOK, DM, G, (int)blockIdx.x, REP_P4, 5);
        pg8::EpiOut E{p.x, p.out};
        pg8::gemm_phase<pg8::EpiOut, pg8::StaticOrder, true, true>(lds, g, S, E);
    }
#undef IN
#undef SEAM
}

#ifndef N_LAUNCHES
#define N_LAUNCHES 1
#endif
extern "C" void kernel_launch(void* const* d_in, const int* in_sizes, int n_in, void* d_out, int out_size, void* d_ws, size_t ws_size, hipStream_t stream) {
    static int grid = 0;
    if (grid == 0) {
        if (n_in != 11 || in_sizes[0] != TOK * DM || out_size != TOK * DM || ws_size < WS_END) { fprintf(stderr, "kernel_launch: unexpected shapes (n_in %d in0 %d out %d ws %zu need %zu)\n", n_in, n_in > 0 ? in_sizes[0] : -1, out_size, ws_size, (size_t)WS_END); grid = -1; return; }
        int dev = 0, cus = 0, per_cu = 0;
        (void)hipGetDevice(&dev); (void)hipDeviceGetAttribute(&cus, hipDeviceAttributeMultiprocessorCount, dev);
        if (hipFuncSetAttribute((const void*)hybrid_fwd, hipFuncAttributeMaxDynamicSharedMemorySize, LDS_TOTAL) != hipSuccess) { fprintf(stderr, "kernel_launch: hipFuncSetAttribute failed\n"); grid = -1; return; }
        if (hipOccupancyMaxActiveBlocksPerMultiprocessor(&per_cu, (const void*)hybrid_fwd, 512, LDS_TOTAL) != hipSuccess || per_cu < 1) { fprintf(stderr, "kernel_launch: occupancy query says %d blocks/CU\n", per_cu); grid = -1; return; }
        if (per_cu > 1) per_cu = 1;
        grid = cus * per_cu;
    }
    if (grid < 0) return;
    Params p{};
    p.x = (const float*)d_in[0]; p.norm_g = (const float*)d_in[1]; p.w_in = (const float*)d_in[2]; p.q_g = (const float*)d_in[3]; p.k_g = (const float*)d_in[4];
    p.sgu_g = (const float*)d_in[5]; p.w_s = (const float*)d_in[6]; p.b_s = (const float*)d_in[7]; p.w_a = (const float*)d_in[8]; p.w_b = (const float*)d_in[9]; p.w_out = (const float*)d_in[10];
    p.out = (float*)d_out; p.ws = (unsigned char*)d_ws;
#if N_LAUNCHES == 1
    if (hipMemsetAsync((char*)d_ws + WS_BAR, 0, 16384, stream) != hipSuccess) { fprintf(stderr, "kernel_launch: barrier memset failed\n"); return; }
    p.ph_lo = 0; p.ph_hi = 5;
    void* args[] = {&p};
    hipError_t e = hipLaunchCooperativeKernel((const void*)hybrid_fwd, dim3(grid), dim3(512), args, LDS_TOTAL, stream);
    if (e != hipSuccess) fprintf(stderr, "cooperative launch failed: %s (grid %d)\n", hipGetErrorString(e), grid);
#else
    for (int ph = 0; ph < 5; ++ph) { p.ph_lo = ph; p.ph_hi = ph + 1; hipLaunchKernelGGL(hybrid_fwd, dim3(grid), dim3(512), LDS_TOTAL, stream, p); }
#endif
}
```
